# Optimizing an MI355X kernel written in HIP

```python
import math
import jax, jax.numpy as jnp
from jax import lax
import numpy as np

D_MODEL = 4096
BATCH = 4
SEQ = 4096
DEPTH = 1

MIX_WIDTH = D_MODEL
REC_WIDTH = MIX_WIDTH // 2
ATTN_WIDTH = MIX_WIDTH - REC_WIDTH
HEAD_DIM = 128
N_ATTN_HEADS = ATTN_WIDTH // HEAD_DIM
N_REC_HEADS = 16
REC_HEAD_DIM = REC_WIDTH // N_REC_HEADS
CONV_WIDTH = 4
LRU_C = 8.0
DILATED_PATTERNS = ((128, 1), (512, 4), (2048, 16))
BLOCK = 128
REL_BUCKETS = 32
REL_MAX_DISTANCE = 2048
D_FF = ((8 * D_MODEL + 3 * 256 - 1) // (3 * 256)) * 256
N_ADA = 6
EPS = 1e-6
NEG_INF = -1e30

kernel_name = "hybrid_rglru_dilated_attn_block"


def rms_norm(x, g):
    x32 = x.astype(jnp.float32)
    y = x32 * lax.rsqrt(jnp.mean(x32 * x32, axis=-1, keepdims=True) + EPS) * g.astype(jnp.float32)
    return y.astype(x.dtype)


def t5_bucket(n):
    max_exact = REL_BUCKETS // 2
    nf = jnp.maximum(n, 1).astype(jnp.float32)
    large = max_exact + (jnp.log(nf / max_exact) / math.log(REL_MAX_DISTANCE / max_exact)
                         * (REL_BUCKETS - max_exact)).astype(jnp.int32)
    large = jnp.minimum(large, REL_BUCKETS - 1)
    return jnp.where(n < max_exact, n, large)


def causal_conv(x, w, b):
    C = x.shape[-1]
    y = lax.conv_general_dilated(x, w[:, None, :].astype(x.dtype), window_strides=(1,),
                                 padding=((CONV_WIDTH - 1, 0),),
                                 dimension_numbers=('NWC', 'WIO', 'NWC'),
                                 feature_group_count=C)
    return y + b.astype(x.dtype)


def rg_lru(xr, w_a, b_a, w_i, b_i, lam):
    B, S, R = xr.shape
    x32 = xr.astype(jnp.float32)
    xh = x32.reshape(B, S, N_REC_HEADS, REC_HEAD_DIM)
    r = jax.nn.sigmoid(jnp.einsum('bshi,hij->bshj', xh, w_a.astype(jnp.float32)).reshape(B, S, R)
                       + b_a.astype(jnp.float32))
    i = jax.nn.sigmoid(jnp.einsum('bshi,hij->bshj', xh, w_i.astype(jnp.float32)).reshape(B, S, R)
                       + b_i.astype(jnp.float32))
    log_a = -LRU_C * r * jax.nn.softplus(-lam.astype(jnp.float32))
    a = jnp.exp(log_a)
    u = jnp.sqrt(-jnp.expm1(2.0 * log_a)) * (i * x32)

    def combine(left, right):
        a1, b1 = left
        a2, b2 = right
        return a1 * a2, a2 * b1 + b2

    _, h = lax.associative_scan(combine, (a, u), axis=1)
    return h


def dilated_branch(q, k, v, rel_bias, window, dil):
    B, S, H, Dh = q.shape
    span = BLOCK * dil
    S_pad = -(-S // span) * span
    pad = S_pad - S
    L = S_pad // dil
    nb = L // BLOCK

    def split(t):
        t = jnp.pad(t, ((0, 0), (0, pad), (0, 0), (0, 0)))
        t = t.reshape(B, L, dil, H, Dh).transpose(0, 2, 1, 3, 4)
        return t.reshape(B, dil, nb, BLOCK, H, Dh)

    def with_prev(t):
        prev = jnp.concatenate([jnp.zeros_like(t[:, :, :1]), t[:, :, :-1]], axis=2)
        return jnp.concatenate([prev, t], axis=3)

    qb = split(q)
    kc = with_prev(split(k))
    vc = with_prev(split(v))

    s = jnp.einsum('brnqhd,brnkhd->brnhqk', qb, kc) * (HEAD_DIM ** -0.5)
    qi = jnp.arange(BLOCK, dtype=jnp.int32)[:, None]
    kj = jnp.arange(2 * BLOCK, dtype=jnp.int32)[None, :]
    dist = qi + BLOCK - kj
    band = (dist >= 0) & (dist <= window // dil)
    blk = jnp.arange(nb, dtype=jnp.int32)[:, None, None]
    valid = band[None] & ((blk > 0) | (kj[None] >= BLOCK))
    bias = rel_bias.astype(jnp.float32)[t5_bucket(jnp.maximum(dist, 0) * dil)]
    s = s + bias.transpose(2, 0, 1)[None, None, None]
    s = jnp.where(valid[None, None, :, None], s, NEG_INF)

    m = jnp.max(s, axis=-1, keepdims=True)
    e = jnp.exp(s - m)
    den = jnp.sum(e, axis=-1)
    o = jnp.einsum('brnhqk,brnkhd->brnqhd', e, vc) / den.transpose(0, 1, 2, 4, 3)[..., None]
    lse = (m[..., 0] + jnp.log(den)).transpose(0, 1, 2, 4, 3)

    o = o.reshape(B, dil, L, H, Dh).transpose(0, 2, 1, 3, 4).reshape(B, S_pad, H, Dh)[:, :S]
    lse = lse.reshape(B, dil, L, H).transpose(0, 2, 1, 3).reshape(B, S_pad, H)[:, :S]
    return o, lse


def dilated_attention(q, k, v, rel_bias):
    q, k, v = (t.astype(jnp.float32) for t in (q, k, v))
    outs, lses = [], []
    for window, dil in DILATED_PATTERNS:
        o, lse = dilated_branch(q, k, v, rel_bias, window, dil)
        outs.append(o)
        lses.append(lse)
    w = jax.nn.softmax(jnp.stack(lses, axis=0), axis=0)
    return jnp.sum(w[..., None] * jnp.stack(outs, axis=0), axis=0)


def swiglu(h, w_gate, w_up, w_down):
    return (jax.nn.silu(h @ w_gate) * (h @ w_up)) @ w_down


def setup_inputs(seed: int = 0) -> dict:
    key = jax.random.key(seed)
    ks = jax.random.split(key, 24)
    f32 = jnp.float32

    def nrm(k, shape, scale):
        return jax.random.normal(k, shape, f32) * scale

    a8 = jax.random.uniform(ks[13], (DEPTH, REC_WIDTH), f32, 0.9, 0.999)
    a = a8 ** (1.0 / LRU_C)
    lru_lambda = jnp.log(a) - jnp.log1p(-a)
    return {
        "x": nrm(ks[0], (BATCH, SEQ, D_MODEL), 1.0),
        "c": nrm(ks[1], (BATCH, D_MODEL), 1.0),
        "ada_w": nrm(ks[2], (DEPTH, D_MODEL, N_ADA * D_MODEL), 0.5 * D_MODEL ** -0.5),
        "ada_b": nrm(ks[3], (DEPTH, N_ADA * D_MODEL), 0.01),
        "norm1_g": 1.0 + nrm(ks[4], (DEPTH, D_MODEL), 0.02),
        "norm2_g": 1.0 + nrm(ks[5], (DEPTH, D_MODEL), 0.02),
        "w_in": nrm(ks[6], (DEPTH, D_MODEL, 2 * REC_WIDTH + 3 * ATTN_WIDTH), D_MODEL ** -0.5),
        "conv_w": nrm(ks[7], (DEPTH, CONV_WIDTH, REC_WIDTH), CONV_WIDTH ** -0.5),
        "conv_b": nrm(ks[8], (DEPTH, REC_WIDTH), 0.01),
        "rg_w_a": nrm(ks[9], (DEPTH, N_REC_HEADS, REC_HEAD_DIM, REC_HEAD_DIM), REC_HEAD_DIM ** -0.5),
        "rg_b_a": nrm(ks[10], (DEPTH, REC_WIDTH), 0.01),
        "rg_w_i": nrm(ks[11], (DEPTH, N_REC_HEADS, REC_HEAD_DIM, REC_HEAD_DIM), REC_HEAD_DIM ** -0.5),
        "rg_b_i": nrm(ks[12], (DEPTH, REC_WIDTH), 0.01),
        "lru_lambda": lru_lambda,
        "rel_bias": nrm(ks[14], (REL_BUCKETS, N_ATTN_HEADS), 0.5),
        "gnorm_rec": 1.0 + nrm(ks[15], (DEPTH, REC_WIDTH), 0.02),
        "gnorm_attn": 1.0 + nrm(ks[16], (DEPTH, ATTN_WIDTH), 0.02),
        "w_out": nrm(ks[17], (DEPTH, MIX_WIDTH, D_MODEL), MIX_WIDTH ** -0.5),
        "w_gate": nrm(ks[18], (DEPTH, D_MODEL, D_FF), D_MODEL ** -0.5),
        "w_up": nrm(ks[19], (DEPTH, D_MODEL, D_FF), D_MODEL ** -0.5),
        "w_down": nrm(ks[20], (DEPTH, D_FF, D_MODEL), D_FF ** -0.5),
        "final_g": 1.0 + nrm(ks[21], (D_MODEL,), 0.02),
    }


def reference(x, c, ada_w, ada_b, norm1_g, norm2_g, w_in, conv_w, conv_b, rg_w_a, rg_b_a,
              rg_w_i, rg_b_i, lru_lambda, rel_bias, gnorm_rec, gnorm_attn, w_out,
              w_gate, w_up, w_down, final_g):
    B, S, D = x.shape
    cond = jax.nn.silu(c)
    col_splits = [REC_WIDTH, 2 * REC_WIDTH, 2 * REC_WIDTH + ATTN_WIDTH, 2 * REC_WIDTH + 2 * ATTN_WIDTH]
    for l in range(DEPTH):
        mod = cond @ ada_w[l] + ada_b[l]
        sh1, sc1, g1, sh2, sc2, g2 = jnp.split(mod, N_ADA, axis=-1)

        h = rms_norm(x, norm1_g[l]) * (1.0 + sc1[:, None]) + sh1[:, None]
        proj = h @ w_in[l]
        xr, yg, q, k, v = jnp.split(proj, col_splits, axis=-1)
        xr = causal_conv(xr, conv_w[l], conv_b[l])
        rec = rg_lru(xr, rg_w_a[l], rg_b_a[l], rg_w_i[l], rg_b_i[l], lru_lambda[l])
        rec = rec * jax.nn.gelu(yg.astype(jnp.float32))
        att = dilated_attention(q.reshape(B, S, N_ATTN_HEADS, HEAD_DIM),
                                k.reshape(B, S, N_ATTN_HEADS, HEAD_DIM),
                                v.reshape(B, S, N_ATTN_HEADS, HEAD_DIM),
                                rel_bias).reshape(B, S, ATTN_WIDTH)
        mixed = jnp.concatenate([rms_norm(rec.astype(x.dtype), gnorm_rec[l]),
                                 rms_norm(att.astype(x.dtype), gnorm_attn[l])], axis=-1)
        x = x + g1[:, None] * (mixed @ w_out[l])

        h = rms_norm(x, norm2_g[l]) * (1.0 + sc2[:, None]) + sh2[:, None]
        x = x + g2[:, None] * swiglu(h, w_gate[l], w_up[l], w_down[l])
    return rms_norm(x, final_g)
```

```cpp
#include <hip/hip_runtime.h>
#include <cstdio>
#include <cstdint>
namespace pg8 {
#define PG8_LAS __attribute__((address_space(3)))
typedef unsigned short bf16_t;
typedef short bf16x8 __attribute__((ext_vector_type(8)));
typedef float f32x4 __attribute__((ext_vector_type(4)));
typedef unsigned u32x4 __attribute__((ext_vector_type(4)));
constexpr int BM = 256, BK = 64, HALF = 128, HTB = HALF * BK * 2  , STAGE_BYTES = 8 * HTB, NXCD = 8;
#ifndef PG8_WGM
#define PG8_WGM 8
#endif
constexpr int WGM = PG8_WGM;

__host__ __device__ __forceinline__ int lds_byte(int r, int c) { const int st = (r >> 4) * 2 + (c >> 5), rr = r & 15, cc = c & 31, ob = rr * 64 + cc * 2; return st * 1024 + (ob ^ (((ob >> 9) & 1) << 5)); }
__host__ __device__ __forceinline__ void stage_rc(int b, int& R, int& C) { const int st = b / 1024, sb = b % 1024, swz = sb ^ (((sb >> 9) & 1) << 5); R = (st >> 1) * 16 + swz / 64; C = (st & 1) * 32 + (swz % 64) / 2; }
__host__ __device__ __forceinline__ int perm32(int rho) { const int n = rho >> 4, i = rho & 15; return 8 * (i >> 2) + 4 * n + (i & 3); }

struct Unit { int pm, pn; };
struct Gemm { const bf16_t* A; const bf16_t* Bt; int M, N, K; };

struct StaticOrder {
    int nM, nN, nwg, G, c, wgm;
    __host__ __device__ void init(int M, int N, int G_, int c_, int wgm_ = WGM) { nM = M / BM; nN = N / BM; nwg = nM * nN; G = G_; c = c_; wgm = wgm_; }
    __host__ __device__ bool next(int i, Unit& u) const {
        const long L = (long)i * G + c; if (L >= nwg) return false;
        int wgid = (int)L; { const int q = nwg / NXCD, r = nwg % NXCD, xcd = wgid % NXCD, off = wgid / NXCD; wgid = (xcd < r ? xcd * (q + 1) : r * (q + 1) + (xcd - r) * q) + off; }
        const int nig = wgm * nN, gid = wgid / nig, fm = gid * wgm, gsz = (nM - fm) < wgm ? (nM - fm) : wgm;
        u.pm = fm + ((wgid % nig) % gsz); u.pn = (wgid % nig) / gsz;
        return true;
    }
    __device__ __forceinline__ void a_ready(const Unit&) const {}
    __device__ __forceinline__ void done(const Unit&) const {}
};


__device__ __forceinline__ unsigned cvt_pk_bf16(float lo, float hi) { unsigned r; asm volatile("v_cvt_pk_bf16_f32 %0, %1, %2" : "=v"(r) : "v"(lo), "v"(hi)); return r; }

constexpr int M_TOK = 16384;
struct EpiBf16Plain {
    static constexpr bool PERM = true, AFTER_DRAIN = false;
    bf16_t* O; int ldc;
    __device__ __forceinline__ void operator()(const f32x4 (&acc)[2][2][4][2], const Unit& u, int wr, int wc, int fr, int fq) const {
        const int row0 = u.pm * BM + wr * 64 + fr, col0 = u.pn * BM + wc * 32 + 8 * fq;
#pragma unroll
        for (int ai = 0; ai < 2; ++ai)
#pragma unroll
            for (int m = 0; m < 4; ++m) { bf16_t* rowp = O + (size_t)(row0 + ai * HALF + m * 16) * ldc + col0;
#pragma unroll
                for (int bj = 0; bj < 2; ++bj) { const f32x4 v0 = acc[ai][bj][m][0], v1 = acc[ai][bj][m][1];
                    u32x4 w; w.x = cvt_pk_bf16(v0[0], v0[1]); w.y = cvt_pk_bf16(v0[2], v0[3]); w.z = cvt_pk_bf16(v1[0], v1[1]); w.w = cvt_pk_bf16(v1[2], v1[3]);
                    *(u32x4*)(rowp + bj * HALF) = w; } }
    }
};
struct EpiProj {
    static constexpr bool PERM = true, AFTER_DRAIN = false;
    bf16_t* O; int seq, nh;
    __device__ __forceinline__ void operator()(const f32x4 (&acc)[2][2][4][2], const Unit& u, int wr, int wc, int fr, int fq) const {
        const int rowp = u.pm * BM, b = rowp / seq, colt = u.pn * BM, which = colt / (nh * 128), head0 = (colt % (nh * 128)) / 128;
        const int t0 = rowp % seq + wr * 64 + fr, d = wc * 32 + 8 * fq;
#pragma unroll
        for (int ai = 0; ai < 2; ++ai)
#pragma unroll
            for (int m = 0; m < 4; ++m) { const int t = t0 + ai * HALF + m * 16; const int rp = which < 2 ? t : ((t & 15) << 8) + (t >> 4);
#pragma unroll
                for (int bj = 0; bj < 2; ++bj) { const f32x4 v0 = acc[ai][bj][m][0], v1 = acc[ai][bj][m][1];
                    u32x4 w; w.x = cvt_pk_bf16(v0[0], v0[1]); w.y = cvt_pk_bf16(v0[2], v0[3]); w.z = cvt_pk_bf16(v1[0], v1[1]); w.w = cvt_pk_bf16(v1[2], v1[3]);
                                        *(u32x4*)(O + ((size_t)((which * (M_TOK / seq) + b) * nh + head0 + bj) * seq + rp) * 128 + d) = w; } }
    }
};
struct EpiResGate {
    static constexpr bool PERM = false, AFTER_DRAIN = false;
    const float* base; float* out; int ldc; const float* gate; int gate_stride; int rows_per_batch;
    __device__ __forceinline__ void operator()(const f32x4 (&acc)[2][2][4][2], const Unit& u, int wr, int wc, int fr, int fq) const {
        const int row0 = u.pm * BM + wr * 64 + fr, col0 = u.pn * BM + wc * 32 + 4 * fq;
        const float* gp = gate + (size_t)((u.pm * BM) / rows_per_batch) * gate_stride + col0;
        f32x4 gv[2][2];
#pragma unroll
        for (int bj = 0; bj < 2; ++bj)
#pragma unroll
            for (int n = 0; n < 2; ++n) gv[bj][n] = *(const f32x4*)(gp + bj * HALF + n * 16);
#pragma unroll
        for (int ai = 0; ai < 2; ++ai)
#pragma unroll
            for (int m = 0; m < 4; ++m) { const size_t off = (size_t)(row0 + ai * HALF + m * 16) * ldc + col0;
#pragma unroll
                for (int bj = 0; bj < 2; ++bj)
#pragma unroll
                    for (int n = 0; n < 2; ++n) { const f32x4 bs = *(const f32x4*)(base + off + bj * HALF + n * 16);
                        *(f32x4*)(out + off + bj * HALF + n * 16) = bs + gv[bj][n] * acc[ai][bj][m][n]; }
                asm volatile("" ::: "memory"); }
    }
};
struct EpiSwiGLU {
    static constexpr bool PERM = true, AFTER_DRAIN = false;
    bf16_t* O; int ldc;
    __device__ __forceinline__ static float silu_mul(float g, float u) { return g * __builtin_amdgcn_rcpf(1.0f + __expf(-g)) * u; }
    __device__ __forceinline__ void operator()(const f32x4 (&acc)[2][2][4][2], const Unit& u, int wr, int wc, int fr, int fq) const {
        const int row0 = u.pm * BM + wr * 64 + fr, col0 = u.pn * HALF + wc * 32 + 8 * fq;
#pragma unroll
        for (int ai = 0; ai < 2; ++ai)
#pragma unroll
            for (int m = 0; m < 4; ++m) { bf16_t* rowp = O + (size_t)(row0 + ai * HALF + m * 16) * ldc + col0;
                const f32x4 g0 = acc[ai][0][m][0], g1 = acc[ai][0][m][1], u0 = acc[ai][1][m][0], u1 = acc[ai][1][m][1];
                u32x4 w;
                w.x = cvt_pk_bf16(silu_mul(g0[0], u0[0]), silu_mul(g0[1], u0[1])); w.y = cvt_pk_bf16(silu_mul(g0[2], u0[2]), silu_mul(g0[3], u0[3]));
                w.z = cvt_pk_bf16(silu_mul(g1[0], u1[0]), silu_mul(g1[1], u1[1])); w.w = cvt_pk_bf16(silu_mul(g1[2], u1[2]), silu_mul(g1[3], u1[3]));
                                *(u32x4*)rowp = w; }
    }
};

template <class Epi, class Sched, bool ALIGN_EPI = false, bool SP2 = false>
__device__ __forceinline__ void gemm_phase(PG8_LAS unsigned char* lds, const Gemm g, const Sched& S, const Epi& E) {
    int tid_ = threadIdx.x; asm volatile("" : "+v"(tid_));
    const int tid = tid_, wid = __builtin_amdgcn_readfirstlane(tid >> 6), lane = tid & 63, wr = wid >> 2, wc = wid & 3, fr = lane & 15, fq = lane >> 4;
    const int K = g.K, nt = K / BK;
    unsigned voffA[2], voffB[2];
#pragma unroll
    for (int i = 0; i < 2; ++i) { int R, C; stage_rc(tid * 16 + i * 8192, R, C); const int Rb = Epi::PERM ? ((R & ~31) + perm32(R & 31)) : R;
        voffA[i] = (unsigned)(R * K + C) * 2u; voffB[i] = (unsigned)(Rb * K + C) * 2u; }
    const size_t kstep = (size_t)(BK * 2);
    const size_t hstep = (size_t)HALF * K * 2;
    const size_t tstep = 2 * hstep;
    const unsigned ldsw = (unsigned)wid * 1024u;
    const int aoff = lds_byte(wr * 64 + fr, fq * 8), boff = lds_byte(wc * 32 + fr, fq * 8);
#define PG8_SA(b, h) (((b) * 2 + (h)) * HTB)
#define PG8_SB(b, h) ((4 + (b) * 2 + (h)) * HTB)
#define PG8_STAGE(bufoff, gbase, voff) do { _Pragma("unroll") for (int _i = 0; _i < 2; ++_i) \
        __builtin_amdgcn_global_load_lds((const unsigned*)((const char*)(gbase) + (voff)[_i]), (PG8_LAS unsigned*)(lds + (bufoff) + ldsw + _i * 8192), 16, 0, 0); } while (0)
#define PG8_LDA(dst, b, h) do { _Pragma("unroll") for (int m = 0; m < 4; ++m) _Pragma("unroll") for (int k = 0; k < 2; ++k) dst[m][k] = *(const PG8_LAS bf16x8*)(lds + PG8_SA(b, h) + aoff + m * 2048 + k * 1024); } while (0)
#define PG8_LDB(dst, b, h) do { _Pragma("unroll") for (int n = 0; n < 2; ++n) _Pragma("unroll") for (int k = 0; k < 2; ++k) dst[n][k] = *(const PG8_LAS bf16x8*)(lds + PG8_SB(b, h) + boff + n * 2048 + k * 1024); } while (0)
#define PG8_MMA(ai, bj, At, Bt) do { __builtin_amdgcn_s_setprio(1); _Pragma("unroll") for (int m = 0; m < 4; ++m) _Pragma("unroll") for (int n = 0; n < 2; ++n) _Pragma("unroll") for (int k = 0; k < 2; ++k) \
        acc[ai][bj][m][n] = __builtin_amdgcn_mfma_f32_16x16x32_bf16(Bt[n][k], At[m][k], acc[ai][bj][m][n], 0, 0, 0); __builtin_amdgcn_s_setprio(0); } while (0)
#define PG8_WAIT_V(n) asm volatile("s_waitcnt vmcnt(" #n ")" ::: "memory")
#define PG8_WAIT_L(n) asm volatile("s_waitcnt lgkmcnt(" #n ")" ::: "memory")
#define PG8_BAR __builtin_amdgcn_s_barrier()
#define PG8_SCHED __builtin_amdgcn_sched_barrier(0)
    Unit cur, nxt; int ui = 0;
    if (!S.next(0, cur)) return;
    f32x4 acc[2][2][4][2];
#pragma unroll
    for (int a = 0; a < 2; ++a)
#pragma unroll
        for (int b = 0; b < 2; ++b)
#pragma unroll
            for (int m = 0; m < 4; ++m)
#pragma unroll
                for (int n = 0; n < 2; ++n) acc[a][b][m][n] = (f32x4){0.f, 0.f, 0.f, 0.f};
    bf16x8 At[4][2], B0[2][2], B1[2][2];
    const char* cA = (const char*)g.A + (size_t)cur.pm * tstep; const char* cB = (const char*)g.Bt + (size_t)cur.pn * tstep;
    S.a_ready(cur);
    if constexpr (SP2) {
        PG8_STAGE(PG8_SB(0, 0), cB, voffB); PG8_STAGE(PG8_SB(0, 1), cB + hstep, voffB); PG8_STAGE(PG8_SA(0, 0), cA, voffA); PG8_STAGE(PG8_SA(0, 1), cA + hstep, voffA);
        if (wr == 1) PG8_BAR;
        PG8_WAIT_V(2); PG8_BAR;
        PG8_STAGE(PG8_SB(1, 0), cB + kstep, voffB); PG8_STAGE(PG8_SA(1, 0), cA + kstep, voffA); PG8_STAGE(PG8_SB(1, 1), cB + hstep + kstep, voffB);
        PG8_WAIT_V(6); PG8_BAR;
    } else {
        PG8_STAGE(PG8_SB(0, 0), cB, voffB); PG8_STAGE(PG8_SA(0, 0), cA, voffA); PG8_STAGE(PG8_SB(0, 1), cB + hstep, voffB); PG8_STAGE(PG8_SA(0, 1), cA + hstep, voffA);
        if (wr == 1) PG8_BAR;
        PG8_WAIT_V(4); PG8_BAR;
        PG8_STAGE(PG8_SB(1, 0), cB + kstep, voffB); PG8_STAGE(PG8_SA(1, 0), cA + kstep, voffA); PG8_STAGE(PG8_SB(1, 1), cB + hstep + kstep, voffB);
        PG8_WAIT_V(6); PG8_BAR;
    }
    for (;;) {
        const bool has_next = S.next(ui + 1, nxt);
        const char* nA = has_next ? (const char*)g.A + (size_t)nxt.pm * tstep : cA; const char* nB = has_next ? (const char*)g.Bt + (size_t)nxt.pn * tstep : cB;
        for (int t = 0; t < nt; t += 2) {
            const bool last = (t == nt - 2);
            const char* a1 = cA + (size_t)(t + 1) * kstep;
            const char* a2 = last ? nA : cA + (size_t)(t + 2) * kstep; const char* b2 = last ? nB : cB + (size_t)(t + 2) * kstep;
            const char* a3 = a2 + kstep; const char* b3 = b2 + kstep;
            if (last && has_next) S.a_ready(nxt);
            if constexpr (SP2) {
            PG8_LDB(B0, 0, 0); PG8_LDB(B1, 0, 1); PG8_SCHED; PG8_LDA(At, 0, 0); PG8_STAGE(PG8_SA(1, 1), a1 + hstep, voffA);
            PG8_WAIT_V(8); PG8_WAIT_L(0); PG8_BAR; PG8_MMA(0, 0, At, B0); PG8_MMA(0, 1, At, B1); PG8_BAR; PG8_SCHED;
            PG8_LDA(At, 0, 1); PG8_STAGE(PG8_SB(0, 0), b2, voffB); PG8_STAGE(PG8_SB(0, 1), b2 + hstep, voffB); PG8_STAGE(PG8_SA(0, 0), a2, voffA);
            PG8_WAIT_V(8); PG8_WAIT_L(0); PG8_BAR; PG8_MMA(1, 0, At, B0); PG8_MMA(1, 1, At, B1); PG8_BAR; PG8_SCHED;
            PG8_LDB(B0, 1, 0); PG8_LDB(B1, 1, 1); PG8_SCHED; PG8_LDA(At, 1, 0); PG8_STAGE(PG8_SA(0, 1), a2 + hstep, voffA);
            PG8_WAIT_V(8); PG8_WAIT_L(0); PG8_BAR; PG8_MMA(0, 0, At, B0); PG8_MMA(0, 1, At, B1); PG8_BAR; PG8_SCHED;
            PG8_LDA(At, 1, 1); PG8_STAGE(PG8_SB(1, 0), b3, voffB); PG8_STAGE(PG8_SB(1, 1), b3 + hstep, voffB); PG8_STAGE(PG8_SA(1, 0), a3, voffA);
            PG8_WAIT_V(8); PG8_WAIT_L(0); PG8_BAR; PG8_MMA(1, 0, At, B0); PG8_MMA(1, 1, At, B1); PG8_BAR; PG8_SCHED;
            } else {
            PG8_LDB(B0, 0, 0); PG8_SCHED; PG8_LDA(At, 0, 0); PG8_STAGE(PG8_SA(1, 1), a1 + hstep, voffA);
            PG8_WAIT_L(8); PG8_BAR; PG8_WAIT_L(0); PG8_MMA(0, 0, At, B0); PG8_BAR; PG8_SCHED;
            PG8_LDB(B1, 0, 1); PG8_STAGE(PG8_SB(0, 0), b2, voffB);
            PG8_BAR; PG8_WAIT_L(0); PG8_MMA(0, 1, At, B1); PG8_BAR;
            PG8_LDA(At, 0, 1); PG8_STAGE(PG8_SA(0, 0), a2, voffA);
            PG8_BAR; PG8_WAIT_L(0); PG8_MMA(1, 0, At, B0); PG8_BAR; PG8_SCHED;
            PG8_STAGE(PG8_SB(0, 1), b2 + hstep, voffB);
            PG8_WAIT_V(6); PG8_BAR; PG8_MMA(1, 1, At, B1); PG8_BAR;
            PG8_LDB(B0, 1, 0); PG8_SCHED; PG8_LDA(At, 1, 0); PG8_STAGE(PG8_SA(0, 1), a2 + hstep, voffA);
            PG8_WAIT_L(8); PG8_BAR; PG8_WAIT_L(0); PG8_MMA(0, 0, At, B0); PG8_BAR; PG8_SCHED;
            PG8_LDB(B1, 1, 1); PG8_STAGE(PG8_SB(1, 0), b3, voffB);
            PG8_BAR; PG8_WAIT_L(0); PG8_MMA(0, 1, At, B1); PG8_BAR;
            PG8_LDA(At, 1, 1); PG8_STAGE(PG8_SA(1, 0), a3, voffA);
            PG8_BAR; PG8_WAIT_L(0); PG8_MMA(1, 0, At, B0); PG8_BAR; PG8_SCHED;
            PG8_STAGE(PG8_SB(1, 1), b3 + hstep, voffB);
            PG8_WAIT_V(6); PG8_BAR; PG8_MMA(1, 1, At, B1); PG8_BAR;
            }
        }
        if constexpr (ALIGN_EPI) { if (wr == 0) PG8_BAR; }
        if constexpr (!Epi::AFTER_DRAIN) { E(acc, cur, wr, wc, fr, fq); S.done(cur); }
        if (!has_next) break;
#pragma unroll
        for (int a = 0; a < 2; ++a)
#pragma unroll
            for (int b = 0; b < 2; ++b)
#pragma unroll
                for (int m = 0; m < 4; ++m)
#pragma unroll
                    for (int n = 0; n < 2; ++n) acc[a][b][m][n] = (f32x4){0.f, 0.f, 0.f, 0.f};
        cur = nxt; cA = nA; cB = nB; ++ui;
        if constexpr (ALIGN_EPI) { if (wr == 1) PG8_BAR; }
    }
    PG8_WAIT_V(0);
    if constexpr (!ALIGN_EPI) { if (wr == 0) PG8_BAR; }
    PG8_BAR;
    if constexpr (Epi::AFTER_DRAIN) { E.fused(acc, cur, wr, wc, fr, fq, lds, wid, lane); S.done(cur); }
#undef PG8_SA
#undef PG8_SB
#undef PG8_STAGE
#undef PG8_LDA
#undef PG8_LDB
#undef PG8_MMA
#undef PG8_WAIT_V
#undef PG8_WAIT_L
#undef PG8_BAR
#undef PG8_SCHED
}
}

#ifndef PG8_SP2
#define PG8_SP2 true
#endif
#ifndef PG8_ALIGN
#define PG8_ALIGN true
#endif

constexpr int NWAVES = 8, NTHR = 512;
constexpr int BATCH = 4, SEQ = 4096, D = 4096, M = BATCH * SEQ, RW = 2048, AW = 2048, HD = 128, NH = 16;
constexpr int NPROJ = 10240, DFF = 11008, NGU = 2 * DFF, NADA = 6 * D;
constexpr int T_XR = 0, T_YG = 1, T_Q = 2, T_K = 3, T_V = 4;
__host__ __device__ constexpr size_t proj_base(int which, int b, int h) { return ((size_t)((which * BATCH + b) * NH + h) * SEQ) * 128; }
__host__ __device__ constexpr int tpos(int t) { return ((t & 15) << 8) + (t >> 4); }
constexpr float EPS = 1e-6f;
constexpr int RG_TC = 64, RG_NCH = SEQ / RG_TC;
constexpr int ADA_KS = 8, ADA_KCH = D / ADA_KS;
constexpr size_t MiB = 1u << 20;
constexpr size_t WS_CTL = 0, CTL_ZERO_BYTES = 1 * MiB;
constexpr size_t WS_MOD = 1 * MiB, WS_BIAS = 2 * MiB, WS_WAT = 3 * MiB, WS_WIT = 4 * MiB, WS_MODP = 5 * MiB, WS_AGG = 8 * MiB, WS_LSE = 12 * MiB;
constexpr size_t WS_WIN = 16 * MiB, WS_WOUT = 96 * MiB, WS_WGU = 128 * MiB, WS_WDN = 300 * MiB, WS_HB = 386 * MiB;
constexpr size_t WS_PROJ = 514 * MiB, WS_REC = 834 * MiB, WS_OP = 898 * MiB, WS_X1 = 1090 * MiB, WS_HB2 = 1346 * MiB, WS_END = 1474 * MiB;
constexpr size_t WS_U = 514 * MiB;
static_assert(WS_WIN + (size_t)NPROJ * D * 2 <= WS_WOUT && WS_WOUT + (size_t)D * D * 2 <= WS_WGU && WS_WGU + (size_t)NGU * D * 2 <= WS_WDN && WS_WDN + (size_t)D * DFF * 2 <= WS_HB, "ws map 1");
static_assert(WS_HB + (size_t)M * D * 2 <= WS_PROJ && WS_PROJ + (size_t)M * NPROJ * 2 <= WS_REC && WS_REC + (size_t)M * RW * 2 <= WS_OP && WS_OP + (size_t)3 * M * AW * 2 <= WS_X1 && WS_X1 + (size_t)M * D * 4 <= WS_END, "ws map 2");
static_assert(WS_U + (size_t)M * DFF * 2 <= WS_X1 && WS_HB2 + (size_t)M * D * 2 <= WS_END, "ws map 3");
static_assert(WS_MODP + (size_t)ADA_KS * BATCH * NADA * 4 <= WS_AGG && WS_AGG + (size_t)BATCH * NH * RG_NCH * 256 * 4 <= WS_LSE && WS_LSE + (size_t)3 * M * NH * 4 <= WS_WIN, "ws map 4");
constexpr int CW_BAR = 4096;
constexpr size_t WS_SSQ2 = 192 * 1024;
static_assert(WS_SSQ2 + (size_t)M * 4 <= CTL_ZERO_BYTES, "ctl map 2");
constexpr size_t WS_PCNT = 64 * 1024;
static_assert((CW_BAR + 3456) * 4 <= WS_PCNT && WS_PCNT + 2 * 64 * 256 <= 128 * 1024, "ctl map 3");
constexpr size_t WS_SSQ3 = 128 * 1024;
static_assert((CW_BAR + 3456) * 4 <= WS_SSQ3 && WS_SSQ3 + (size_t)M * 4 <= CTL_ZERO_BYTES, "ctl map");
constexpr int LDS_BYTES = 147456;
constexpr int MISC_OFF = 147456 - 256;
constexpr int ATT_PITCH = 272, ATT_KS = 0, ATT_VS = 256 * ATT_PITCH, ATT_BS = 2 * 256 * ATT_PITCH;
static_assert(ATT_BS + 160 * 4 <= MISC_OFF, "attention LDS");
constexpr int RG_XB = 0, RG_XF = RG_TC * 272, RG_AS = RG_XF + RG_TC * 128 * 4, RG_US = RG_AS + RG_TC * 128 * 4, RG_SUB = RG_US + RG_TC * 128 * 4, RG_YG = RG_SUB + 2 * 4 * 128 * 4;
static_assert(RG_YG + RG_TC * 256 <= MISC_OFF && (RG_TC + 3) * 256 <= RG_TC * 128 * 4 && RG_TC * 256 <= RG_TC * 272, "rg LDS");
constexpr int RG_SPAN = 16, RG_NSPAN = BATCH * NH * (RG_NCH / RG_SPAN);

#define GAS __attribute__((address_space(1)))
#define LAS __attribute__((address_space(3)))
typedef unsigned short bf16;
typedef unsigned v4u __attribute__((ext_vector_type(4)));
typedef unsigned v2u __attribute__((ext_vector_type(2)));
typedef float f32x4 __attribute__((ext_vector_type(4)));
typedef short bf16x8 __attribute__((ext_vector_type(8)));
typedef short s16x4 __attribute__((ext_vector_type(4)));
typedef GAS unsigned gu32;
#define LDS_WAIT() asm volatile("s_waitcnt lgkmcnt(0)" ::: "memory")
#define VM_WAIT() asm volatile("s_waitcnt vmcnt(0)" ::: "memory")
__device__ __forceinline__ unsigned f2bf(float f) { unsigned u = __builtin_bit_cast(unsigned, f); return (u + 0x7fffu + ((u >> 16) & 1u)) >> 16; }
__device__ __forceinline__ unsigned pk2(float lo, float hi) { unsigned r; asm("v_cvt_pk_bf16_f32 %0, %1, %2" : "=v"(r) : "v"(lo), "v"(hi)); return r; }
__device__ __forceinline__ float bf_lo(unsigned w) { return __builtin_bit_cast(float, w << 16); }
__device__ __forceinline__ float bf_hi(unsigned w) { return __builtin_bit_cast(float, w & 0xffff0000u); }
__device__ __forceinline__ float wave_sum(float v) {
#pragma unroll
    for (int o = 1; o < 64; o <<= 1) v += __shfl_xor(v, o);
    return v;
}
__device__ __forceinline__ float sigmoidf_(float x) { return __builtin_amdgcn_rcpf(1.0f + __expf(-x)); }
__device__ __forceinline__ float gelu_tanh(float x) {
    constexpr float c0 = (float)(-2.0 * 0.7978845608028654 * 1.4426950408889634), c1 = (float)(-2.0 * 0.7978845608028654 * 0.044715 * 1.4426950408889634);
    const float t = x * x; return x * __builtin_amdgcn_rcpf(1.0f + __builtin_amdgcn_exp2f(x * __builtin_fmaf(t, c1, c0))); }

#define XB_TMO      128
#define XB_XCNT(j)  (256  + 64 * (j))
#define XB_XSUB(j)  (1280 + 64 * (j))
#define XB_XGEN(j)  (2304 + 64 * (j))
#define XB_TOP      3328
#define XB_TOPGEN   3392
#define XCD_BAR_WORDS 3456
#define XB_SPIN_CAP (1u << 18)

__device__ __forceinline__ unsigned xb_ld(unsigned* p)              { return __hip_atomic_load(p, __ATOMIC_RELAXED, __HIP_MEMORY_SCOPE_AGENT); }
__device__ __forceinline__ unsigned xb_add(unsigned* p, unsigned v) { return __hip_atomic_fetch_add(p, v, __ATOMIC_RELAXED, __HIP_MEMORY_SCOPE_AGENT); }
__device__ __forceinline__ unsigned xb_xcc_id() { return (unsigned)__builtin_amdgcn_s_getreg((3 << 11) | 20) & 0xFu; }
#define XB_SPIN(cond, bar) do { unsigned _sp = 0; while (cond) { __builtin_amdgcn_s_sleep(1); \
    if ((++_sp & 255u) == 0u) { if (xb_ld(&(bar)[XB_TMO])) break; if (_sp > XB_SPIN_CAP) { atomicAdd(&(bar)[XB_TMO], 1u); break; } } } } while (0)

struct XcdBarrier {
    unsigned* bar; unsigned x;
    volatile LAS unsigned* st;
};

__device__ __forceinline__ XcdBarrier xcd_barrier_post(unsigned* bar, volatile LAS unsigned* st) {
    XcdBarrier b; b.bar = bar; b.x = xb_xcc_id(); b.st = st;
    if (threadIdx.x == 0) (void)xb_add(&bar[XB_XCNT(b.x)], 1u);
    return b;
}
__device__ __forceinline__ void xcd_barrier_complete(unsigned* bar, unsigned x, unsigned& nloc, unsigned& nx) {
    const unsigned G = gridDim.x * gridDim.y * gridDim.z;
    unsigned sum, cnt, mine, sp = 0u;
    for (;;) {
        sum = 0u; cnt = 0u; mine = 0u;
#pragma unroll
        for (unsigned j = 0; j < 16; ++j) { const unsigned c = xb_ld(&bar[XB_XCNT(j)]); sum += c; cnt += (c > 0u) ? 1u : 0u; mine = (j == x) ? c : mine; }
        if (sum == G) break;
        __builtin_amdgcn_s_sleep(1);
        if ((++sp & 255u) == 0u) { if (xb_ld(&bar[XB_TMO])) break; if (sp > XB_SPIN_CAP) { atomicAdd(&bar[XB_TMO], 1u); break; } }
    }
    nloc = mine > 0u ? mine : 1u; nx = cnt > 0u ? cnt : 1u;
}

__device__ __forceinline__ void xcd_barrier(const XcdBarrier& b) {
    asm volatile("s_waitcnt vmcnt(0)" ::: "memory");
    __syncthreads();
    if (threadIdx.x == 0) {
        unsigned* bar = b.bar;
        __builtin_amdgcn_s_waitcnt(0);
        unsigned nloc = b.st[0], nx = b.st[1];
        if (nloc == 0u) { xcd_barrier_complete(bar, b.x, nloc, nx); b.st[0] = nloc; b.st[1] = nx; }
        const unsigned old = xb_add(&bar[XB_XSUB(b.x)], 1u);
        const unsigned gen = old / nloc;
        if (old + 1u == (gen + 1u) * nloc) {
            __builtin_amdgcn_fence(__ATOMIC_RELEASE, "agent");
            asm volatile("s_waitcnt vmcnt(0)" ::: "memory");
            const unsigned og = xb_add(&bar[XB_TOP], 1u);
            const unsigned tg = og / nx;
            if (og + 1u == (tg + 1u) * nx) xb_add(&bar[XB_TOPGEN], 1u);
            else XB_SPIN(xb_ld(&bar[XB_TOPGEN]) == tg, bar);
            __builtin_amdgcn_fence(__ATOMIC_ACQUIRE, "agent");
            xb_add(&bar[XB_XGEN(b.x)], 1u);
            asm volatile("s_waitcnt vmcnt(0)" ::: "memory");
        } else {
            XB_SPIN(xb_ld(&bar[XB_XGEN(b.x)]) == gen, bar);
            __builtin_amdgcn_fence(__ATOMIC_ACQUIRE, "agent");
            asm volatile("s_waitcnt vmcnt(0)" ::: "memory");
        }
    }
    __syncthreads();
}

struct KArgs { const float* in[22]; float* out; unsigned char* ws; };
typedef const __attribute__((address_space(4))) KArgs* KArgsP;
__device__ __forceinline__ KArgsP kargs() { KArgsP p = (KArgsP)__builtin_amdgcn_kernarg_segment_ptr(); asm volatile("" : "+s"(p)); return p; }
struct Frame {
    LAS unsigned char* lds;
    volatile LAS unsigned* MISC;
    gu32* ctl;
    int tid, lane, wave;
    int vcu, G;
    KArgsP A;
    __device__ __forceinline__ const float* x() const { return A->in[0]; }
    __device__ __forceinline__ const float* c() const { return A->in[1]; }
    __device__ __forceinline__ const float* ada_w() const { return A->in[2]; }
    __device__ __forceinline__ const float* ada_b() const { return A->in[3]; }
    __device__ __forceinline__ const float* norm1_g() const { return A->in[4]; }
    __device__ __forceinline__ const float* norm2_g() const { return A->in[5]; }
    __device__ __forceinline__ const float* w_in() const { return A->in[6]; }
    __device__ __forceinline__ const float* conv_w() const { return A->in[7]; }
    __device__ __forceinline__ const float* conv_b() const { return A->in[8]; }
    __device__ __forceinline__ const float* rg_w_a() const { return A->in[9]; }
    __device__ __forceinline__ const float* rg_b_a() const { return A->in[10]; }
    __device__ __forceinline__ const float* rg_w_i() const { return A->in[11]; }
    __device__ __forceinline__ const float* rg_b_i() const { return A->in[12]; }
    __device__ __forceinline__ const float* lam() const { return A->in[13]; }
    __device__ __forceinline__ const float* rel_bias() const { return A->in[14]; }
    __device__ __forceinline__ const float* gn_rec() const { return A->in[15]; }
    __device__ __forceinline__ const float* gn_att() const { return A->in[16]; }
    __device__ __forceinline__ const float* w_out() const { return A->in[17]; }
    __device__ __forceinline__ const float* w_gate() const { return A->in[18]; }
    __device__ __forceinline__ const float* w_up() const { return A->in[19]; }
    __device__ __forceinline__ const float* w_down() const { return A->in[20]; }
    __device__ __forceinline__ const float* final_g() const { return A->in[21]; }
    __device__ __forceinline__ float* out() const { return A->out; }
    __device__ __forceinline__ bf16* PG() const { return (bf16*)(A->ws + WS_REC); }
    __device__ __forceinline__ float* SSQ3() const { return (float*)(A->ws + WS_SSQ3); }
    __device__ __forceinline__ unsigned* PCNT(int bank) const { return (unsigned*)(A->ws + WS_PCNT) + bank * 64 * 64; }
    __device__ __forceinline__ float* SSQ2() const { return (float*)(A->ws + WS_SSQ2); }
    __device__ __forceinline__ bf16* HB2() const { return (bf16*)(A->ws + WS_HB2); }
    __device__ __forceinline__ float* MOD() const { return (float*)(A->ws + WS_MOD); }
    __device__ __forceinline__ float* BIAS() const { return (float*)(A->ws + WS_BIAS); }
    __device__ __forceinline__ float* MODP() const { return (float*)(A->ws + WS_MODP); }
    __device__ __forceinline__ float* AGG() const { return (float*)(A->ws + WS_AGG); }
    __device__ __forceinline__ float* LSE() const { return (float*)(A->ws + WS_LSE); }
    __device__ __forceinline__ float* X1() const { return (float*)(A->ws + WS_X1); }
    __device__ __forceinline__ bf16* WAT() const { return (bf16*)(A->ws + WS_WAT); }
    __device__ __forceinline__ bf16* WIT() const { return (bf16*)(A->ws + WS_WIT); }
    __device__ __forceinline__ bf16* WIN() const { return (bf16*)(A->ws + WS_WIN); }
    __device__ __forceinline__ bf16* WOUT() const { return (bf16*)(A->ws + WS_WOUT); }
    __device__ __forceinline__ bf16* WGU() const { return (bf16*)(A->ws + WS_WGU); }
    __device__ __forceinline__ bf16* WDN() const { return (bf16*)(A->ws + WS_WDN); }
    __device__ __forceinline__ bf16* HB() const { return (bf16*)(A->ws + WS_HB); }
    __device__ __forceinline__ bf16* PROJ() const { return (bf16*)(A->ws + WS_PROJ); }
    __device__ __forceinline__ bf16* REC() const { return (bf16*)(A->ws + WS_REC); }
    __device__ __forceinline__ bf16* OP() const { return (bf16*)(A->ws + WS_OP); }
    __device__ __forceinline__ bf16* U() const { return (bf16*)(A->ws + WS_U); }
};

__device__ __forceinline__ void tr_item(const float* W, int N, bf16* WT, int Kp, int k0, int n0, int drow0, LAS float* scr, int lane) {
    { const GAS float* src = (const GAS float*)W + (size_t)(k0 + (lane >> 3)) * N + n0 + (lane & 7) * 4;
      LAS float* dst = scr + (lane >> 3) * 33 + (lane & 7) * 4; const size_t rs8 = (size_t)8 * N;
      f32x4 v[8];
#pragma unroll
      for (int i = 0; i < 8; ++i) v[i] = *(const GAS f32x4*)(src + i * rs8);
#pragma unroll
      for (int i = 0; i < 8; ++i) { dst[i * 8 * 33 + 0] = v[i].x; dst[i * 8 * 33 + 1] = v[i].y; dst[i * 8 * 33 + 2] = v[i].z; dst[i * 8 * 33 + 3] = v[i].w; } }
    LDS_WAIT(); asm volatile("" ::: "memory");
    const int c = lane & 7;
#pragma unroll
    for (int j = 0; j < 4; ++j) { const int n = (lane >> 3) + 8 * j; const LAS float* s = scr + (8 * c) * 33 + n;
        v4u o; o.x = pk2(s[0 * 33], s[1 * 33]); o.y = pk2(s[2 * 33], s[3 * 33]); o.z = pk2(s[4 * 33], s[5 * 33]); o.w = pk2(s[6 * 33], s[7 * 33]);
        *(GAS v4u*)(WT + (size_t)(drow0 + n) * Kp + k0 + 8 * c) = o; }
    LDS_WAIT(); asm volatile("" ::: "memory");
}
constexpr int TR_IN = (D / 64) * (NPROJ / 32), TR_OUT = (D / 64) * (D / 32), TR_G = (D / 64) * (DFF / 32), TR_DN = (DFF / 64) * (D / 32), TR_RG = NH * 2 * 4;
constexpr int TR_TOTAL = TR_IN + TR_OUT + 2 * TR_G + 2 * TR_RG;
__device__ __forceinline__ void tr_dispatch(Frame& F, int it, LAS float* scr) {
    int r = it;
    if (r < TR_IN) { const int nnb = NPROJ / 32, kb = r / nnb, nb = r % nnb; tr_item(F.w_in(), NPROJ, F.WIN(), D, 64 * kb, 32 * nb, 32 * nb, scr, F.lane); return; } r -= TR_IN;
    if (r < TR_OUT) { const int nnb = D / 32, kb = r / nnb, nb = r % nnb; tr_item(F.w_out(), D, F.WOUT(), D, 64 * kb, 32 * nb, 32 * nb, scr, F.lane); return; } r -= TR_OUT;
    if (r < TR_G) { const int nnb = DFF / 32, kb = r / nnb, nb = r % nnb, n0 = 32 * nb; tr_item(F.w_gate(), DFF, F.WGU(), D, 64 * kb, n0, 256 * (n0 >> 7) + (n0 & 127), scr, F.lane); return; } r -= TR_G;
    if (r < TR_G) { const int nnb = DFF / 32, kb = r / nnb, nb = r % nnb, n0 = 32 * nb; tr_item(F.w_up(), DFF, F.WGU(), D, 64 * kb, n0, 256 * (n0 >> 7) + 128 + (n0 & 127), scr, F.lane); return; } r -= TR_G;
    if (r < TR_RG) { const int hh = r >> 3, kb = (r >> 2) & 1, nb = r & 3; tr_item(F.rg_w_a() + hh * 16384, 128, F.WAT() + hh * 16384, 128, 64 * kb, 32 * nb, 32 * nb, scr, F.lane); return; } r -= TR_RG;
    { const int hh = r >> 3, kb = (r >> 2) & 1, nb = r & 3; tr_item(F.rg_w_i() + hh * 16384, 128, F.WIT() + hh * 16384, 128, 64 * kb, 32 * nb, 32 * nb, scr, F.lane); }
}
__device__ __forceinline__ void ada_item(Frame& F, int cg, int ks, LAS float* scr) {
    const int kbase = ADA_KCH * ks;
#pragma unroll
    for (int j = 0; j < ADA_KCH / 64; ++j) { const int kk = F.lane + 64 * j;
#pragma unroll
        for (int b = 0; b < BATCH; ++b) { const float cv = F.c()[(size_t)b * D + kbase + kk]; scr[kk * 4 + b] = cv * sigmoidf_(cv); } }
    LDS_WAIT(); asm volatile("" ::: "memory");
    const int col = 256 * cg + 4 * F.lane;
    const float* wp = F.ada_w() + (size_t)kbase * NADA + col;
    f32x4 a0 = {0.f, 0.f, 0.f, 0.f}, a1 = a0, a2 = a0, a3 = a0;
#pragma unroll 8
    for (int k = 0; k < ADA_KCH; ++k) { const f32x4 w = *(const GAS f32x4*)(wp + (size_t)k * NADA); const f32x4 cv = *(const LAS f32x4*)(scr + 4 * k);
        a0 += cv.x * w; a1 += cv.y * w; a2 += cv.z * w; a3 += cv.w * w; }
    float* o = F.MODP() + (size_t)(ks * BATCH) * NADA + col;
    *(GAS f32x4*)(o) = a0; *(GAS f32x4*)(o + NADA) = a1; *(GAS f32x4*)(o + 2 * NADA) = a2; *(GAS f32x4*)(o + 3 * NADA) = a3;
    LDS_WAIT(); asm volatile("" ::: "memory");
}
__device__ __forceinline__ int t5_bucket(int n) {
    if (n < 16) return n;
    const float nf = (float)n;
    int large = 16 + (int)(logf(nf / 16.0f) / 4.852030263919617f * 16.0f);
    return large < 31 ? large : 31;
}
__device__ __forceinline__ void p0_prologue(Frame& F) {
    LAS float* scr = (LAS float*)(F.lds + F.wave * 16384);
    const int gw = F.vcu * NWAVES + F.wave, NGW = F.G * NWAVES;
    const int n_ada = (NADA / 256) * ADA_KS, n_adaw = F.G * 3;
    if (F.wave < 3) for (int it = F.vcu * 3 + F.wave; it < n_ada; it += n_adaw) ada_item(F, it % (NADA / 256), it / (NADA / 256), scr);
    const int NA = 9 * NGW < TR_TOTAL ? 9 * NGW : TR_TOTAL;
    for (int it = gw; it < NA; it += NGW) tr_dispatch(F, it, scr);
    if (F.wave >= 3) { const int gw2 = F.vcu * 5 + (F.wave - 3), NGW2 = F.G * 5;
        for (int it = NA + gw2; it < TR_TOTAL; it += NGW2) tr_dispatch(F, it, scr); }
    if (F.vcu == 0) for (int i = F.tid; i < 3 * 129 * NH; i += NTHR) { const int h = i % NH, dist = (i / NH) % 129, p = i / (NH * 129); F.BIAS()[i] = F.rel_bias()[t5_bucket(dist << (2 * p)) * NH + h]; }
}
__device__ __forceinline__ void tr_down_tail(Frame& F, int rank, int nw_cu) {
    LAS float* scr = (LAS float*)(F.lds + F.wave * 16384);
    for (int it = rank * NWAVES + F.wave; it < TR_DN; it += nw_cu * NWAVES) { const int nnb = D / 32, kb = it / nnb, nb = it % nnb;
        tr_item(F.w_down(), D, F.WDN(), DFF, 64 * kb, 32 * nb, 32 * nb, scr, F.lane); }
}
__device__ __forceinline__ void norm_mod_row(const float* xrow, bf16* orow, const float* g, const float* sc, const float* sh, int lane) {
    const GAS f32x4* xr = (const GAS f32x4*)xrow + lane;
    f32x4 v[16]; float s = 0.f;
#pragma unroll
    for (int j = 0; j < 16; ++j) { v[j] = xr[64 * j]; s += (v[j].x * v[j].x + v[j].y * v[j].y) + (v[j].z * v[j].z + v[j].w * v[j].w); }
    const float rs = __builtin_amdgcn_rsqf(wave_sum(s) * (1.0f / D) + EPS);
    GAS v2u* o8 = (GAS v2u*)orow + lane;
#pragma unroll
    for (int j = 0; j < 16; ++j) { const int cidx = lane + 64 * j;
        const f32x4 gv = ((const GAS f32x4*)g)[cidx], scv = ((const GAS f32x4*)sc)[cidx], shv = ((const GAS f32x4*)sh)[cidx];
        const f32x4 h = v[j] * rs * gv * (1.0f + scv) + shv;
        v2u w; w.x = pk2(h.x, h.y); w.y = pk2(h.z, h.w); o8[64 * j] = w; }
}
__device__ __forceinline__ void norm_row_f32(const float* xrow, float* orow, const float* g, int lane) {
    const GAS f32x4* xr = (const GAS f32x4*)xrow + lane;
    f32x4 v[16]; float s = 0.f;
#pragma unroll
    for (int j = 0; j < 16; ++j) { v[j] = xr[64 * j]; s += (v[j].x * v[j].x + v[j].y * v[j].y) + (v[j].z * v[j].z + v[j].w * v[j].w); }
    const float rs = __builtin_amdgcn_rsqf(wave_sum(s) * (1.0f / D) + EPS);
    GAS f32x4* o = (GAS f32x4*)orow + lane;
#pragma unroll
    for (int j = 0; j < 16; ++j) { const f32x4 gv = ((const GAS f32x4*)g)[lane + 64 * j]; o[64 * j] = v[j] * rs * gv; }
}

__device__ __forceinline__ void panel_arrive_wait(unsigned* cnt, unsigned want, unsigned* tmo, int wid, int lane) {
    asm volatile("s_waitcnt vmcnt(0)" ::: "memory");
    if (lane == 0) (void)__hip_atomic_fetch_add(cnt, 1u, __ATOMIC_RELAXED, __HIP_MEMORY_SCOPE_AGENT);
    if (wid == 0) { unsigned sp = 0;
        while ((unsigned)__builtin_amdgcn_readfirstlane(__hip_atomic_load(cnt, __ATOMIC_RELAXED, __HIP_MEMORY_SCOPE_AGENT)) < want) {
            __builtin_amdgcn_s_sleep(2);
            if ((++sp & 255u) == 0u) { if (xb_ld(tmo)) break; if (sp > (1u << 20)) { if (lane == 0) atomicAdd(tmo, 1u); break; } } }
        __builtin_amdgcn_fence(__ATOMIC_ACQUIRE, "agent"); }
    asm volatile("s_waitcnt vmcnt(0) lgkmcnt(0)" ::: "memory");
    __syncthreads();
}
struct OneUnitOrder {
    pg8::StaticOrder S; int r;
    __device__ bool next(int i, pg8::Unit& u) const { return i == 0 && S.next(r, u); }
    __device__ __forceinline__ void a_ready(const pg8::Unit&) const {}
    __device__ __forceinline__ void done(const pg8::Unit&) const {}
};
struct PanelRoundOrder {
    int c, rounds;
    __device__ bool next(int i, pg8::Unit& u) const { if (i >= rounds) return false; const int x = c & 7, k = c >> 3; u.pm = 16 * i + 4 * (x >> 1) + (k & 3); u.pn = 8 * (x & 1) + (k >> 2); return true; }
    __device__ __forceinline__ void a_ready(const pg8::Unit&) const {}
    __device__ __forceinline__ void done(const pg8::Unit&) const {}
};
struct EpiFinalNorm {
    static constexpr bool PERM = false, AFTER_DRAIN = false;
    __device__ __forceinline__ void operator()(pg8::f32x4 (&acc)[2][2][4][2], const pg8::Unit& u, int wr, int wc, int fr, int fq) const { fused(acc, u, wr, wc, fr, fq, nullptr, wr * 4 + wc, fq * 16 + fr); }
    const float* base; float* out; int ldc; const float* gate; int gate_stride; int rows_per_batch; float* ssq; const float* fg; const XcdBarrier* bar; unsigned* cnt; float inv_d, eps;
    __device__ __forceinline__ void fused(pg8::f32x4 (&acc)[2][2][4][2], const pg8::Unit& u, int wr, int wc, int fr, int fq, PG8_LAS unsigned char*, int wid, int lane) const {
        using pg8::f32x4; constexpr int BM = pg8::BM, HALF = pg8::HALF;
        const int row0 = u.pm * BM + wr * 64 + fr, col0 = u.pn * BM + wc * 32 + 4 * fq;
        const float* gp = gate + (size_t)((u.pm * BM) / rows_per_batch) * gate_stride + col0;
        { f32x4 gv[2][2];
#pragma unroll
          for (int bj = 0; bj < 2; ++bj)
#pragma unroll
            for (int n = 0; n < 2; ++n) gv[bj][n] = *(const f32x4*)(gp + bj * HALF + n * 16);
#pragma unroll
          for (int ai = 0; ai < 2; ++ai)
#pragma unroll
            for (int m = 0; m < 4; ++m) { const int row = row0 + ai * HALF + m * 16; const size_t off = (size_t)row * ldc + col0; float s = 0.f;
#pragma unroll
                for (int bj = 0; bj < 2; ++bj)
#pragma unroll
                    for (int n = 0; n < 2; ++n) { const f32x4 bs = *(const f32x4*)(base + off + bj * HALF + n * 16);
                        const f32x4 x2 = bs + gv[bj][n] * acc[ai][bj][m][n]; acc[ai][bj][m][n] = x2;
                        s += (x2[0] * x2[0] + x2[1] * x2[1]) + (x2[2] * x2[2] + x2[3] * x2[3]); }
                s += __shfl_xor(s, 16); s += __shfl_xor(s, 32);
                if (fq == 0) atomicAdd(ssq + row, s);
                asm volatile("" ::: "memory"); } }
        panel_arrive_wait(cnt + 64 * u.pm, 16u * NWAVES, bar->bar + XB_TMO, wid, lane);
        const bool bad = xb_ld(bar->bar + XB_TMO) != 0u; const float q = __builtin_nanf("");
        f32x4 fv[2][2];
#pragma unroll
        for (int bj = 0; bj < 2; ++bj)
#pragma unroll
            for (int n = 0; n < 2; ++n) fv[bj][n] = *(const f32x4*)(fg + col0 + bj * HALF + n * 16);
#pragma unroll
        for (int ai = 0; ai < 2; ++ai)
#pragma unroll
            for (int m = 0; m < 4; ++m) { const int row = row0 + ai * HALF + m * 16; const size_t off = (size_t)row * ldc + col0;
                const float sv = __hip_atomic_load(ssq + row, __ATOMIC_RELAXED, __HIP_MEMORY_SCOPE_AGENT);
                const float rs = bad ? q : __builtin_amdgcn_rsqf(sv * inv_d + eps);
#pragma unroll
                for (int bj = 0; bj < 2; ++bj)
#pragma unroll
                    for (int n = 0; n < 2; ++n) *(f32x4*)(out + off + bj * HALF + n * 16) = acc[ai][bj][m][n] * rs * fv[bj][n]; }
    }
};

struct EpiNorm2 {
    static constexpr bool PERM = false, AFTER_DRAIN = false;
    __device__ __forceinline__ void operator()(pg8::f32x4 (&acc)[2][2][4][2], const pg8::Unit& u, int wr, int wc, int fr, int fq) const { fused(acc, u, wr, wc, fr, fq, nullptr, wr * 4 + wc, fq * 16 + fr); }
    const float* base; float* out; int ldc; const float* gate; int gate_stride; int rows_per_batch; float* ssq; bf16* a2; const float* n2g; const float* sc2; const float* sh2; const XcdBarrier* bar; unsigned* cnt; float inv_d, eps;
    __device__ __forceinline__ void fused(pg8::f32x4 (&acc)[2][2][4][2], const pg8::Unit& u, int wr, int wc, int fr, int fq, PG8_LAS unsigned char*, int wid, int lane) const {
        using pg8::f32x4; constexpr int BM = pg8::BM, HALF = pg8::HALF;
        const int row0 = u.pm * BM + wr * 64 + fr, col0 = u.pn * BM + wc * 32 + 4 * fq, b = (u.pm * BM) / rows_per_batch;
        { const float* gp = gate + (size_t)b * gate_stride + col0; f32x4 gv[2][2];
#pragma unroll
          for (int bj = 0; bj < 2; ++bj)
#pragma unroll
            for (int n = 0; n < 2; ++n) gv[bj][n] = *(const f32x4*)(gp + bj * HALF + n * 16);
#pragma unroll
          for (int ai = 0; ai < 2; ++ai)
#pragma unroll
            for (int m = 0; m < 4; ++m) { const int row = row0 + ai * HALF + m * 16; const size_t off = (size_t)row * ldc + col0; float s = 0.f;
#pragma unroll
                for (int bj = 0; bj < 2; ++bj)
#pragma unroll
                    for (int n = 0; n < 2; ++n) { const f32x4 bs = *(const f32x4*)(base + off + bj * HALF + n * 16);
                        const f32x4 x1 = bs + gv[bj][n] * acc[ai][bj][m][n]; acc[ai][bj][m][n] = x1; *(f32x4*)(out + off + bj * HALF + n * 16) = x1;
                        s += (x1[0] * x1[0] + x1[1] * x1[1]) + (x1[2] * x1[2] + x1[3] * x1[3]); }
                s += __shfl_xor(s, 16); s += __shfl_xor(s, 32);
                if (fq == 0) atomicAdd(ssq + row, s);
                asm volatile("" ::: "memory"); } }
        panel_arrive_wait(cnt + 64 * u.pm, 16u * NWAVES, bar->bar + XB_TMO, wid, lane);
        f32x4 cs[2][2], sv[2][2];
#pragma unroll
        for (int bj = 0; bj < 2; ++bj)
#pragma unroll
            for (int n = 0; n < 2; ++n) { const int c = col0 + bj * HALF + n * 16;
                cs[bj][n] = *(const f32x4*)(n2g + c) * (*(const f32x4*)(sc2 + (size_t)b * gate_stride + c) + 1.0f); sv[bj][n] = *(const f32x4*)(sh2 + (size_t)b * gate_stride + c); }
#pragma unroll
        for (int ai = 0; ai < 2; ++ai)
#pragma unroll
            for (int m = 0; m < 4; ++m) { const int row = row0 + ai * HALF + m * 16; const size_t off = (size_t)row * ldc + col0;
                const float rs = __builtin_amdgcn_rsqf(__hip_atomic_load(ssq + row, __ATOMIC_RELAXED, __HIP_MEMORY_SCOPE_AGENT) * inv_d + eps);
#pragma unroll
                for (int bj = 0; bj < 2; ++bj)
#pragma unroll
                    for (int n = 0; n < 2; ++n) { const f32x4 h = acc[ai][bj][m][n] * rs * cs[bj][n] + sv[bj][n];
                        v2u w; w.x = pk2(h[0], h[1]); w.y = pk2(h[2], h[3]); *(GAS v2u*)(a2 + off + bj * HALF + n * 16) = w; } }
    }
};
__device__ __forceinline__ void rg_issue_loads(const bf16* PROJ, int b, int h, int t0, int tid, v4u (&px)[3], v4u (&py)[2], bool want_y) {
#pragma unroll
    for (int k = 0; k < 3; ++k) { const int id = tid + NTHR * k, row = id >> 4, pc = id & 15, t = t0 - 3 + row; px[k] = (v4u){0u, 0u, 0u, 0u};
        if (id < (RG_TC + 3) * 16 && t >= 0) px[k] = *(const GAS v4u*)(PROJ + proj_base(T_XR, b, h) + (size_t)t * 128 + pc * 8); }
    if (want_y) {
#pragma unroll
        for (int k = 0; k < 2; ++k) { const int id = tid + NTHR * k, row = id >> 4, pc = id & 15; py[k] = *(const GAS v4u*)(PROJ + proj_base(T_YG, b, h) + (size_t)(t0 + row) * 128 + pc * 8); }
    }
}
template <int PASS> __device__ __forceinline__ void rg_span(Frame& F, int s) {
    constexpr int NQ = RG_NCH / RG_SPAN;
    const int bh = s / NQ, q = s % NQ, b = bh / NH, h = bh % NH;
    int tid_ = F.tid; asm volatile("" : "+v"(tid_));
    const int tid = tid_, lane = tid & 63, wave = F.wave;
    LAS unsigned char* XB = F.lds + RG_XB; LAS float* XF = (LAS float*)(F.lds + RG_XF); LAS float* AS = (LAS float*)(F.lds + RG_AS); LAS float* US = (LAS float*)(F.lds + RG_US);
    LAS float* SUBP = (LAS float*)(F.lds + RG_SUB); LAS float* SUBH = SUBP + 4 * 128;
    LAS unsigned char* XRAW = F.lds + RG_AS;
    LAS unsigned char* YG = F.lds + RG_YG;
    LAS unsigned char* OUT = F.lds + RG_XB;
    LAS unsigned char* OUTB = F.lds + RG_XF;
    const int ch0 = (tid & 15) * 8, chg0 = h * 128 + ch0;
    float cw[4][8], cb[8];
#pragma unroll
    for (int j = 0; j < 4; ++j) { const f32x4 w0 = *(const GAS f32x4*)(F.conv_w() + (size_t)j * RW + chg0), w1 = *(const GAS f32x4*)(F.conv_w() + (size_t)j * RW + chg0 + 4);
        cw[j][0] = w0.x; cw[j][1] = w0.y; cw[j][2] = w0.z; cw[j][3] = w0.w; cw[j][4] = w1.x; cw[j][5] = w1.y; cw[j][6] = w1.z; cw[j][7] = w1.w; }
    { const f32x4 b0 = *(const GAS f32x4*)(F.conv_b() + chg0), b1 = *(const GAS f32x4*)(F.conv_b() + chg0 + 4); cb[0] = b0.x; cb[1] = b0.y; cb[2] = b0.z; cb[3] = b0.w; cb[4] = b1.x; cb[5] = b1.y; cb[6] = b1.z; cb[7] = b1.w; }
    const int li = lane & 15, g = lane >> 4, chl = 16 * wave + li, chg = h * 128 + chl;
    bf16x8 wa[4], wi[4];
#pragma unroll
    for (int ks = 0; ks < 4; ++ks) { wa[ks] = *(const GAS bf16x8*)(F.WAT() + (size_t)h * 16384 + chl * 128 + 32 * ks + 8 * g); wi[ks] = *(const GAS bf16x8*)(F.WIT() + (size_t)h * 16384 + chl * 128 + 32 * ks + 8 * g); }
    const float nba = -1.4426950408889634f * F.rg_b_a()[chg], nbi = -1.4426950408889634f * F.rg_b_i()[chg], cl2 = -8.0f * 1.4426950408889634f * log1pf(expf(-F.lam()[chg]));
    const int sc = tid & 127, sub = tid >> 7; constexpr int SUBL = RG_TC / 4;
    float* agg = F.AGG() + (size_t)(bh * NQ) * 256;
    float carry = 0.f, prun = 1.f;
    if (PASS == 2) for (int qq = 0; qq < q; ++qq) carry = agg[qq * 256 + sc] * carry + agg[qq * 256 + 128 + sc];
    v4u px[3], py[2];
    const int tbase = q * RG_SPAN * RG_TC;
    rg_issue_loads(F.PROJ(), b, h, tbase, tid, px, py, PASS >= 2);
    for (int c = 0; c < RG_SPAN; ++c) {
        const int t0 = tbase + c * RG_TC;
#pragma unroll
        for (int k = 0; k < 3; ++k) { const int id = tid + NTHR * k; if (id < (RG_TC + 3) * 16) *(LAS v4u*)(XRAW + id * 16) = px[k]; }
        if (PASS >= 2) {
#pragma unroll
            for (int k = 0; k < 2; ++k) *(LAS v4u*)(YG + (tid + NTHR * k) * 16) = py[k]; }
        if (c + 1 < RG_SPAN) rg_issue_loads(F.PROJ(), b, h, t0 + RG_TC, tid, px, py, PASS >= 2);
        __syncthreads();
#pragma unroll
        for (int it = 0; it < (RG_TC * 16) / NTHR; ++it) { const int tt = (tid + NTHR * it) >> 4;
            float acc[8];
#pragma unroll
            for (int e = 0; e < 8; ++e) acc[e] = cb[e];
#pragma unroll
            for (int j = 0; j < 4; ++j) { const v4u xv = *(const LAS v4u*)(XRAW + (tt + j) * 256 + ch0 * 2);
                acc[0] += cw[j][0] * bf_lo(xv.x); acc[1] += cw[j][1] * bf_hi(xv.x); acc[2] += cw[j][2] * bf_lo(xv.y); acc[3] += cw[j][3] * bf_hi(xv.y);
                acc[4] += cw[j][4] * bf_lo(xv.z); acc[5] += cw[j][5] * bf_hi(xv.z); acc[6] += cw[j][6] * bf_lo(xv.w); acc[7] += cw[j][7] * bf_hi(xv.w); }
            *(LAS f32x4*)(XF + tt * 128 + ch0) = (f32x4){acc[0], acc[1], acc[2], acc[3]}; *(LAS f32x4*)(XF + tt * 128 + ch0 + 4) = (f32x4){acc[4], acc[5], acc[6], acc[7]};
            v4u o; o.x = pk2(acc[0], acc[1]); o.y = pk2(acc[2], acc[3]); o.z = pk2(acc[4], acc[5]); o.w = pk2(acc[6], acc[7]);
            *(LAS v4u*)(XB + tt * 272 + ch0 * 2) = o; }
        __syncthreads();
#pragma unroll
        for (int tb = 0; tb < RG_TC / 16; ++tb) { f32x4 ga = {0.f, 0.f, 0.f, 0.f}, gi = ga;
#pragma unroll
            for (int ks = 0; ks < 4; ++ks) { const bf16x8 xa = *(const LAS bf16x8*)(XB + (16 * tb + li) * 272 + (32 * ks + 8 * g) * 2);
                ga = __builtin_amdgcn_mfma_f32_16x16x32_bf16(xa, wa[ks], ga, 0, 0, 0); gi = __builtin_amdgcn_mfma_f32_16x16x32_bf16(xa, wi[ks], gi, 0, 0, 0); }
#pragma unroll
            for (int rg = 0; rg < 4; ++rg) { const int tok = 16 * tb + 4 * g + rg;
                const float xcv = XF[tok * 128 + chl];
                const float r = __builtin_amdgcn_rcpf(1.0f + __builtin_amdgcn_exp2f(__builtin_fmaf(ga[rg], -1.4426950408889634f, nba)));
                const float iv = __builtin_amdgcn_rcpf(1.0f + __builtin_amdgcn_exp2f(__builtin_fmaf(gi[rg], -1.4426950408889634f, nbi)));
                const float a = __builtin_amdgcn_exp2f(r * cl2);
                const float om = fmaxf(__builtin_fmaf(-a, a, 1.0f), 0.f);
                AS[tok * 128 + chl] = a; US[tok * 128 + chl] = __builtin_amdgcn_sqrtf(om) * (iv * xcv); } }
        __syncthreads();
        { float P = 1.f, H = 0.f;
#pragma unroll
          for (int k = 0; k < SUBL; ++k) { const int t = sub * SUBL + k; const float a = AS[t * 128 + sc], u = US[t * 128 + sc]; H = a * H + u; P *= a; }
          SUBP[sub * 128 + sc] = P; SUBH[sub * 128 + sc] = H; }
        __syncthreads();
        float hs = carry, ps = prun;
        { float cur = carry, pcur = prun;
#pragma unroll
          for (int k = 0; k < 4; ++k) { if (k == sub) { hs = cur; ps = pcur; } const float pk = SUBP[k * 128 + sc]; cur = pk * cur + SUBH[k * 128 + sc]; pcur *= pk; }
          carry = cur; prun = pcur; }
        if (PASS >= 2) {
#pragma unroll
            for (int k = 0; k < SUBL; ++k) { const int t = sub * SUBL + k; const float a = AS[t * 128 + sc], u = US[t * 128 + sc]; hs = a * hs + u;
                const float yg = bf_lo((unsigned)*(const LAS unsigned short*)(YG + t * 256 + sc * 2)); const float gl = gelu_tanh(yg);
                *(LAS unsigned short*)(OUT + t * 256 + sc * 2) = (unsigned short)pk2(hs * gl, 0.f);
                if (PASS == 3) { ps *= a; *(LAS unsigned short*)(OUTB + t * 256 + sc * 2) = (unsigned short)pk2(ps * gl, 0.f); } }
            __syncthreads();
#pragma unroll
            for (int k = 0; k < 2; ++k) { const int id = tid + NTHR * k, row = id >> 4, pc = id & 15;
                *(GAS v4u*)(F.HB() + (size_t)(b * SEQ + t0 + row) * D + h * 128 + pc * 8) = *(const LAS v4u*)(OUT + id * 16);
                if (PASS == 3) *(GAS v4u*)(F.PG() + (size_t)(b * SEQ + t0 + row) * RW + h * 128 + pc * 8) = *(const LAS v4u*)(OUTB + id * 16); }
        }
        __syncthreads();
    }
    if (PASS != 2 && tid < 128) { agg[q * 256 + sc] = prun; agg[q * 256 + 128 + sc] = carry; }
}

constexpr int ATT_VPITCH = 288, ATT_KBYTES = 128 * 256;
constexpr int ATT_SLOT = ATT_KBYTES + 128 * ATT_VPITCH;
static_assert(ATT_SLOT == 2 * 128 * ATT_PITCH, "ring slot size");
__device__ __forceinline__ int att_kswz(int li, int gq) { const int ob = li * 64 + gq * 16; return ob ^ (((ob >> 9) & 1) << 5); }
template <bool MERGE> __device__ __forceinline__ void attn_unit_rq(int j, int k, int& r, int& qb) {
    if (MERGE) { r = 0; qb = 8 * j + k; }
    else if (j < 2) { r = 2 * j + (k >> 3); qb = k & 7; }
    else { r = 8 * (j - 2) + (k >> 1); qb = k & 1; }
}
__device__ __forceinline__ void attn_load_block(const bf16* PROJ, int b, int h, int dsh, int r, int blk, int tid, v4u (&kx)[4], v4u (&vx)[4]) {
#pragma unroll
    for (int it = 0; it < 4; ++it) { const int id = tid + NTHR * it, row = id >> 4, pc = id & 15;
        const size_t off = (size_t)tpos(((128 * blk + row) << dsh) + r) * 128 + pc * 8;
        kx[it] = *(const GAS v4u*)(PROJ + proj_base(T_K, b, h) + off); vx[it] = *(const GAS v4u*)(PROJ + proj_base(T_V, b, h) + off); }
}
__device__ __forceinline__ void attn_load_piece(const bf16* PROJ, int b, int h, int dsh, int r, int blk, int tid, int it, bool more, v4u& kx, v4u& vx) {
    const int id = tid + NTHR * it, row = id >> 4, pc = id & 15;
    const size_t off = more ? (size_t)tpos(((128 * blk + row) << dsh) + r) * 128 + pc * 8 : (size_t)0;
    kx = *(const GAS v4u*)(PROJ + proj_base(T_K, b, h) + off); vx = *(const GAS v4u*)(PROJ + proj_base(T_V, b, h) + off);
}
__device__ __forceinline__ void attn_store_block(LAS unsigned char* slot, int tid, const v4u (&kx)[4], const v4u (&vx)[4]) {
#pragma unroll
    for (int it = 0; it < 4; ++it) { const int id = tid + NTHR * it, row = id >> 4, pc = id & 15;
        *(LAS v4u*)(slot + (row >> 4) * 4096 + (pc >> 2) * 1024 + att_kswz(row & 15, pc & 3)) = kx[it]; *(LAS v4u*)(slot + ATT_KBYTES + row * ATT_VPITCH + pc * 16) = vx[it]; }
}
template <bool MERGE> __device__ __forceinline__ void attn_run(Frame& F, int run) {
    constexpr int NU = MERGE ? 8 : 16;
    const int bh = run >> 2, j = run & 3, b = bh >> 4, h = bh & 15;
    const int p = MERGE ? 0 : (j < 2 ? 1 : 2), dsh = 2 * p;
    int tid_ = F.tid; asm volatile("" : "+v"(tid_));
    const int tid = tid_, lane = tid & 63, wave = F.wave;
    LAS unsigned char* ring = F.lds; LAS float* BS = (LAS float*)(F.lds + 2 * ATT_SLOT);
    if (tid < 160) { const int d = tid - 16; BS[tid] = (d >= 0 && d <= 128) ? 1.4426950408889634f * F.BIAS()[(p * 129 + d) * NH + h] : 0.f; }
    const int li = lane & 15, g = lane >> 4, iq = 16 * wave + li, dl = li - 4 * g;
    const LAS float* bsl = BS + 144 + dl;
    const int q4 = li >> 2, p4 = li & 3, kswz = att_kswz(li, g);
    v4u kx[4], vx[4]; bf16x8 qf[4], qn[4];
    { int r, qb; attn_unit_rq<MERGE>(j, 0, r, qb);
      attn_load_block(F.PROJ(), b, h, dsh, r, qb, tid, kx, vx); attn_store_block(ring, tid, kx, vx);
      if (qb > 0) { attn_load_block(F.PROJ(), b, h, dsh, r, qb - 1, tid, kx, vx); attn_store_block(ring + ATT_SLOT, tid, kx, vx); }
      const int pq = tpos(((qb * 128 + iq) << dsh) + r);
#pragma unroll
      for (int ks = 0; ks < 4; ++ks) qf[ks] = *(const GAS bf16x8*)(F.PROJ() + proj_base(T_Q, b, h) + (size_t)pq * 128 + 32 * ks + 8 * g); }
    __syncthreads();
    for (int k = 0; k < NU; ++k) {
        int r, qb; attn_unit_rq<MERGE>(j, k, r, qb);
        if (k > 0) { attn_store_block(ring + (k & 1) * ATT_SLOT, tid, kx, vx);
#pragma unroll
            for (int ks = 0; ks < 4; ++ks) qf[ks] = qn[ks];
            __syncthreads(); }
        int r2 = 0, qb2 = 0; const bool more = k + 1 < NU; if (more) attn_unit_rq<MERGE>(j, k + 1, r2, qb2);
        const int tq = ((qb * 128 + iq) << dsh) + r, pq = tpos(tq);
        const size_t mq = (size_t)(b * SEQ + tq);
        const size_t oidx = ((size_t)(b * NH + h) * SEQ + pq);
        v2u a1[8], a2[8]; float l1 = 0.f, l2 = 0.f;
        const bf16* o1 = F.OP() + ((size_t)1 * M * NH + oidx) * 128 + 8 * g; const bf16* o2 = F.OP() + ((size_t)2 * M * NH + oidx) * 128 + 8 * g;
        LAS unsigned char* cur = ring + (k & 1) * ATT_SLOT; LAS unsigned char* prv = ring + ((k + 1) & 1) * ATT_SLOT;
        const int xlo = (qb == 0) ? (8 - wave) : 0;
        f32x4 st[9];
        const float scale = 0.08838834764831845f * 1.4426950408889634f;
        float mx = -1e30f;
#pragma unroll
        for (int x = 0; x < 9; ++x) {
            const int T = wave + x; const LAS unsigned char* kb = (T < 8 ? prv + 4096 * T : cur + 4096 * (T - 8)) + kswz;
            f32x4 a = {0.f, 0.f, 0.f, 0.f};
#pragma unroll
            for (int ks = 0; ks < 4; ++ks) a = __builtin_amdgcn_mfma_f32_16x16x32_bf16(*(const LAS bf16x8*)(kb + 1024 * ks), qf[ks], a, 0, 0, 0);
            if (x < 4) attn_load_piece(F.PROJ(), b, h, dsh, r2, qb2, tid, x, more, kx[x], vx[x]);
            if (MERGE && x >= 5) { const int c0 = 2 * (x - 5); const v4u t1 = *(const GAS v4u*)(o1 + 32 * (x - 5)), t2 = *(const GAS v4u*)(o2 + 32 * (x - 5));
                a1[c0] = (v2u){t1.x, t1.y}; a1[c0 + 1] = (v2u){t1.z, t1.w}; a2[c0] = (v2u){t2.x, t2.y}; a2[c0 + 1] = (v2u){t2.z, t2.w}; }
            if (MERGE && x == 4) { l1 = F.LSE()[(size_t)1 * M * NH + oidx]; l2 = F.LSE()[(size_t)2 * M * NH + oidx]; }
            if (x == 4) { const int pq2 = more ? tpos(((qb2 * 128 + iq) << dsh) + r2) : 0;
#pragma unroll
                for (int ks = 0; ks < 4; ++ks) qn[ks] = *(const GAS bf16x8*)(F.PROJ() + proj_base(T_Q, b, h) + (size_t)pq2 * 128 + 32 * ks + 8 * g); }
            const bool live = x >= xlo;
#pragma unroll
            for (int rg = 0; rg < 4; ++rg) { float sv = a[rg] * scale + bsl[-(16 * x + rg)];
                bool ok = live;
                if (x == 0) ok = ok && (dl - rg <= 0);
                if (x == 8) ok = ok && (dl - rg >= 0);
                sv = ok ? sv : -1e30f;
                a[rg] = sv; mx = fmaxf(mx, sv); }
            st[x] = a;
        }
        mx = fmaxf(mx, __shfl_xor(mx, 16)); mx = fmaxf(mx, __shfl_xor(mx, 32));
        float l = 0.f;
#pragma unroll
        for (int x = 0; x < 9; ++x)
#pragma unroll
            for (int rg = 0; rg < 4; ++rg) { const float pv = __builtin_amdgcn_exp2f(st[x][rg] - mx); st[x][rg] = pv; l += pv; }
        l += __shfl_xor(l, 16); l += __shfl_xor(l, 32);
        f32x4 o[8];
#pragma unroll
        for (int cb = 0; cb < 8; ++cb) o[cb] = (f32x4){0.f, 0.f, 0.f, 0.f};
#pragma unroll
        for (int stp = 0; stp < 5; ++stp) { const int x0 = 2 * stp, x1 = x0 + 1;
            const int T0 = (x0 >= xlo) ? wave + x0 : 8, T1 = (x1 < 9 && x1 >= xlo) ? wave + x1 : 8;
            const LAS unsigned char* v0 = (T0 < 8 ? prv + 16 * T0 * ATT_VPITCH : cur + 16 * (T0 - 8) * ATT_VPITCH) + ATT_KBYTES + (4 * g + q4) * ATT_VPITCH + 8 * p4;
            const LAS unsigned char* v1 = (T1 < 8 ? prv + 16 * T1 * ATT_VPITCH : cur + 16 * (T1 - 8) * ATT_VPITCH) + ATT_KBYTES + (4 * g + q4) * ATT_VPITCH + 8 * p4;
            bf16x8 pf; { const unsigned w0 = pk2(st[x0][0], st[x0][1]), w1 = pk2(st[x0][2], st[x0][3]);
                unsigned w2 = 0u, w3 = 0u; if (x1 < 9) { w2 = pk2(st[x1][0], st[x1][1]); w3 = pk2(st[x1][2], st[x1][3]); }
                const v4u wv = {w0, w1, w2, w3}; pf = __builtin_bit_cast(bf16x8, wv); }
            bf16x8 vf[8];
#pragma unroll
            for (int cb = 0; cb < 8; ++cb) {
                const s16x4 a0 = __builtin_amdgcn_ds_read_tr16_b64_v4i16((LAS s16x4*)(v0 + 32 * cb));
                const s16x4 a1 = __builtin_amdgcn_ds_read_tr16_b64_v4i16((LAS s16x4*)(v1 + 32 * cb));
                vf[cb] = (bf16x8){a0[0], a0[1], a0[2], a0[3], a1[0], a1[1], a1[2], a1[3]}; }
            __builtin_amdgcn_sched_barrier(0);
#pragma unroll
            for (int cb = 0; cb < 8; ++cb) o[cb] = __builtin_amdgcn_mfma_f32_16x16x32_bf16(vf[cb], pf, o[cb], 0, 0, 0);
            __builtin_amdgcn_sched_barrier(0); }
        const float inv = 1.0f / l;
        if (!MERGE) {
            bf16* orow = F.OP() + ((size_t)p * M * NH + oidx) * 128 + 8 * g;
#pragma unroll
            for (int i = 0; i < 4; ++i) { v4u w; w.x = pk2(o[2 * i][0] * inv, o[2 * i][1] * inv); w.y = pk2(o[2 * i][2] * inv, o[2 * i][3] * inv);
                w.z = pk2(o[2 * i + 1][0] * inv, o[2 * i + 1][1] * inv); w.w = pk2(o[2 * i + 1][2] * inv, o[2 * i + 1][3] * inv); *(GAS v4u*)(orow + 32 * i) = w; }
            if (g == 0) F.LSE()[(size_t)p * M * NH + oidx] = mx + __builtin_amdgcn_logf(l);
        } else {
            const float l0 = mx + __builtin_amdgcn_logf(l);
            const float lm = fmaxf(l0, fmaxf(l1, l2)); float w0 = __builtin_amdgcn_exp2f(l0 - lm), w1 = __builtin_amdgcn_exp2f(l1 - lm), w2 = __builtin_amdgcn_exp2f(l2 - lm); const float wi = __builtin_amdgcn_rcpf(w0 + w1 + w2); w0 *= wi * inv; w1 *= wi; w2 *= wi;
            bf16* orow = F.HB() + mq * D + RW + h * 128 + 4 * g;
#pragma unroll
            for (int cb = 0; cb < 8; ++cb) { const v2u a = a1[cb], c2 = a2[cb];
                v2u w; w.x = pk2(w0 * o[cb][0] + w1 * bf_lo(a.x) + w2 * bf_lo(c2.x), w0 * o[cb][1] + w1 * bf_hi(a.x) + w2 * bf_hi(c2.x));
                w.y = pk2(w0 * o[cb][2] + w1 * bf_lo(a.y) + w2 * bf_lo(c2.y), w0 * o[cb][3] + w1 * bf_hi(a.y) + w2 * bf_hi(c2.y));
                *(GAS v2u*)(orow + 16 * cb) = w; }
        }
        __syncthreads();
    }
}

__device__ __forceinline__ void groupnorm_rows(Frame& F, int m0, int nrows) {
    int lane_ = F.lane; asm volatile("" : "+v"(lane_)); const int lane = lane_;
    constexpr int NQ = RG_NCH / RG_SPAN;
    const int b = m0 / SEQ, q = (m0 % SEQ) / (RG_SPAN * RG_TC);
    f32x4 gr[4][2], ga[4][2]; float cy[4][8];
#pragma unroll
    for (int j = 0; j < 4; ++j) { const int col = 8 * (lane + 64 * j), hh = col >> 7, chl = col & 127;
        gr[j][0] = *(const GAS f32x4*)(F.gn_rec() + col); gr[j][1] = *(const GAS f32x4*)(F.gn_rec() + col + 4); ga[j][0] = *(const GAS f32x4*)(F.gn_att() + col); ga[j][1] = *(const GAS f32x4*)(F.gn_att() + col + 4);
        const float* agg = F.AGG() + (size_t)((b * NH + hh) * NQ) * 256 + chl;
#pragma unroll
        for (int e = 0; e < 8; ++e) cy[j][e] = 0.f;
        for (int qq = 0; qq < q; ++qq) { const f32x4 p0 = *(const GAS f32x4*)(agg + qq * 256), p1 = *(const GAS f32x4*)(agg + qq * 256 + 4), h0 = *(const GAS f32x4*)(agg + qq * 256 + 128), h1 = *(const GAS f32x4*)(agg + qq * 256 + 132);
            cy[j][0] = p0.x * cy[j][0] + h0.x; cy[j][1] = p0.y * cy[j][1] + h0.y; cy[j][2] = p0.z * cy[j][2] + h0.z; cy[j][3] = p0.w * cy[j][3] + h0.w;
            cy[j][4] = p1.x * cy[j][4] + h1.x; cy[j][5] = p1.y * cy[j][5] + h1.y; cy[j][6] = p1.z * cy[j][6] + h1.z; cy[j][7] = p1.w * cy[j][7] + h1.w; } }
    for (int rr = 0; rr < nrows; ++rr) {
        bf16* row = F.HB() + (size_t)(m0 + rr) * D; const bf16* prow = F.PG() + (size_t)(m0 + rr) * RW;
        v4u aw[4]; float rv[4][8]; float sr = 0.f, sa = 0.f;
#pragma unroll
        for (int j = 0; j < 4; ++j) { const int col = 8 * (lane + 64 * j); const v4u rw = *(const GAS v4u*)(row + col), pw = *(const GAS v4u*)(prow + col); aw[j] = *(const GAS v4u*)(row + RW + col);
            rv[j][0] = bf_lo(rw.x) + bf_lo(pw.x) * cy[j][0]; rv[j][1] = bf_hi(rw.x) + bf_hi(pw.x) * cy[j][1]; rv[j][2] = bf_lo(rw.y) + bf_lo(pw.y) * cy[j][2]; rv[j][3] = bf_hi(rw.y) + bf_hi(pw.y) * cy[j][3];
            rv[j][4] = bf_lo(rw.z) + bf_lo(pw.z) * cy[j][4]; rv[j][5] = bf_hi(rw.z) + bf_hi(pw.z) * cy[j][5]; rv[j][6] = bf_lo(rw.w) + bf_lo(pw.w) * cy[j][6]; rv[j][7] = bf_hi(rw.w) + bf_hi(pw.w) * cy[j][7];
            const float a0 = bf_lo(aw[j].x), a1 = bf_hi(aw[j].x), a2 = bf_lo(aw[j].y), a3 = bf_hi(aw[j].y), a4 = bf_lo(aw[j].z), a5 = bf_hi(aw[j].z), a6 = bf_lo(aw[j].w), a7 = bf_hi(aw[j].w);
#pragma unroll
            for (int e = 0; e < 8; ++e) sr += rv[j][e] * rv[j][e];
            sa += (a0 * a0 + a1 * a1) + (a2 * a2 + a3 * a3) + (a4 * a4 + a5 * a5) + (a6 * a6 + a7 * a7); }
        const float rsr = __builtin_amdgcn_rsqf(wave_sum(sr) * (1.0f / RW) + EPS), rsa = __builtin_amdgcn_rsqf(wave_sum(sa) * (1.0f / AW) + EPS);
#pragma unroll
        for (int j = 0; j < 4; ++j) { const int col = 8 * (lane + 64 * j);
            const f32x4 g0 = gr[j][0] * rsr, g1 = gr[j][1] * rsr, h0 = ga[j][0] * rsa, h1 = ga[j][1] * rsa;
            v4u w; w.x = pk2(rv[j][0] * g0.x, rv[j][1] * g0.y); w.y = pk2(rv[j][2] * g0.z, rv[j][3] * g0.w); w.z = pk2(rv[j][4] * g1.x, rv[j][5] * g1.y); w.w = pk2(rv[j][6] * g1.z, rv[j][7] * g1.w);
            *(GAS v4u*)(row + col) = w;
            v4u z; z.x = pk2(bf_lo(aw[j].x) * h0.x, bf_hi(aw[j].x) * h0.y); z.y = pk2(bf_lo(aw[j].y) * h0.z, bf_hi(aw[j].y) * h0.w);
            z.z = pk2(bf_lo(aw[j].z) * h1.x, bf_hi(aw[j].z) * h1.y); z.w = pk2(bf_lo(aw[j].w) * h1.z, bf_hi(aw[j].w) * h1.w);
            *(GAS v4u*)(row + RW + col) = z; }
    }
}

#ifndef WGM_IN
#define WGM_IN 8
#endif
#ifndef WGM_OUT
#define WGM_OUT 8
#endif
#ifndef WGM_GU
#define WGM_GU 8
#endif
#ifndef WGM_DN
#define WGM_DN 8
#endif
typedef KArgs Args;
__global__ void __launch_bounds__(NTHR, 2) hybrid_block_fwd(Args args) {
    extern __shared__ __attribute__((aligned(16))) unsigned char lds[];
    Frame F;
    F.lds = (LAS unsigned char*)lds;
    F.MISC = (volatile LAS unsigned*)(F.lds + MISC_OFF);
    F.tid = threadIdx.x; F.lane = F.tid & 63; F.wave = __builtin_amdgcn_readfirstlane(F.tid >> 6);
    F.G = gridDim.x; { const int bx = blockIdx.x; F.vcu = (F.G % 8 == 0) ? (bx % 8) * (F.G / 8) + bx / 8 : bx; }
    F.A = kargs();
    F.ctl = (gu32*)(F.A->ws + WS_CTL);
    if (F.tid < 64) ((LAS unsigned*)(F.lds + MISC_OFF))[F.tid] = 0u;
    __syncthreads();
    XcdBarrier bar = xcd_barrier_post((unsigned*)(F.ctl + CW_BAR), F.MISC + 8);
    const int gw = F.vcu * NWAVES + F.wave, NGW = F.G * NWAVES;

    p0_prologue(F);
    xcd_barrier(bar); F.A = kargs();
    for (int i = F.vcu * NTHR + F.tid; i < BATCH * NADA; i += F.G * NTHR) { const int b = i / NADA, n = i % NADA; float s = F.ada_b()[n];
#pragma unroll
        for (int ks = 0; ks < ADA_KS; ++ks) s += F.MODP()[(size_t)(ks * BATCH + b) * NADA + n];
        F.MOD()[i] = s; }
    xcd_barrier(bar); F.A = kargs();
    for (int m = gw; m < M; m += NGW) { const float* mod = F.MOD() + (size_t)(m / SEQ) * NADA; norm_mod_row(F.x() + (size_t)m * D, F.HB() + (size_t)m * D, F.norm1_g(), mod + D, mod, F.lane); }
    xcd_barrier(bar); F.A = kargs();
    { pg8::Gemm g{F.HB(), F.WIN(), M, NPROJ, D}; pg8::StaticOrder S; S.init(M, NPROJ, F.G, (int)blockIdx.x, WGM_IN); pg8::EpiProj E{F.PROJ(), SEQ, NH};
      pg8::gemm_phase<pg8::EpiProj, pg8::StaticOrder, false, PG8_SP2>(F.lds, g, S, E); }
    xcd_barrier(bar); F.A = kargs();
    for (int run = F.vcu; run < BATCH * NH * 4; run += F.G) attn_run<false>(F, run);
    xcd_barrier(bar); F.A = kargs();
    if (F.vcu & 1) { for (int run = F.vcu; run < BATCH * NH * 4; run += F.G) attn_run<true>(F, run); }
    for (int s = F.vcu; s < RG_NSPAN; s += F.G) rg_span<3>(F, s);
    if (!(F.vcu & 1)) { for (int run = F.vcu; run < BATCH * NH * 4; run += F.G) attn_run<true>(F, run); }
    xcd_barrier(bar); F.A = kargs();
    for (int m0 = 8 * gw; m0 < M; m0 += 8 * NGW) groupnorm_rows(F, m0, 8);
    xcd_barrier(bar); F.A = kargs();
    if (F.G == 256) {
        { pg8::Gemm g{F.HB(), F.WOUT(), M, D, D}; PanelRoundOrder S{(int)blockIdx.x, 4};
          EpiNorm2 E{F.x(), F.X1(), D, F.MOD() + 2 * D, NADA, SEQ, F.SSQ2(), F.HB2(), F.norm2_g(), F.MOD() + 4 * D, F.MOD() + 3 * D, &bar, F.PCNT(0), 1.0f / D, EPS};
          pg8::gemm_phase<EpiNorm2, PanelRoundOrder, true, PG8_SP2>(F.lds, g, S, E); }
        xcd_barrier(bar); F.A = kargs();
    } else {
        { pg8::Gemm g{F.HB(), F.WOUT(), M, D, D}; pg8::StaticOrder S; S.init(M, D, F.G, (int)blockIdx.x, WGM_OUT); pg8::EpiResGate E{F.x(), F.X1(), D, F.MOD() + 2 * D, NADA, SEQ};
          pg8::gemm_phase<pg8::EpiResGate, pg8::StaticOrder, PG8_ALIGN, PG8_SP2>(F.lds, g, S, E); }
        xcd_barrier(bar); F.A = kargs();
        for (int m = gw; m < M; m += NGW) { const float* mod = F.MOD() + (size_t)(m / SEQ) * NADA; norm_mod_row(F.X1() + (size_t)m * D, F.HB2() + (size_t)m * D, F.norm2_g(), mod + 4 * D, mod + 3 * D, F.lane); }
        xcd_barrier(bar); F.A = kargs();
    }
    { pg8::Gemm g{F.HB2(), F.WGU(), M, NGU, D}; pg8::StaticOrder S; S.init(M, NGU, F.G, (int)blockIdx.x, WGM_GU); pg8::EpiSwiGLU E{F.U(), DFF};
      pg8::gemm_phase<pg8::EpiSwiGLU, pg8::StaticOrder, false, PG8_SP2>(F.lds, g, S, E);
      const int nun = (M / 256) * (NGU / 256), rem = nun % F.G, bx = (int)blockIdx.x;
      __syncthreads();
      if (rem == 0) tr_down_tail(F, bx, F.G); else if (bx >= rem) tr_down_tail(F, bx - rem, F.G - rem); }
    xcd_barrier(bar); F.A = kargs();
    if (F.G == 256) {
        { pg8::Gemm g{F.U(), F.WDN(), M, D, DFF}; PanelRoundOrder S{(int)blockIdx.x, 4};
          EpiFinalNorm E{F.X1(), F.out(), D, F.MOD() + 5 * D, NADA, SEQ, F.SSQ3(), F.final_g(), &bar, F.PCNT(1), 1.0f / D, EPS};
          pg8::gemm_phase<EpiFinalNorm, PanelRoundOrder, true, PG8_SP2>(F.lds, g, S, E); }
    } else {
        { pg8::Gemm g{F.U(), F.WDN(), M, D, DFF}; pg8::StaticOrder S; S.init(M, D, F.G, (int)blockIdx.x, WGM_DN); pg8::EpiResGate E{F.X1(), F.out(), D, F.MOD() + 5 * D, NADA, SEQ};
          pg8::gemm_phase<pg8::EpiResGate, pg8::StaticOrder, PG8_ALIGN, PG8_SP2>(F.lds, g, S, E); }
        xcd_barrier(bar); F.A = kargs();
        const bool bad = xb_ld((unsigned*)(F.ctl + CW_BAR) + XB_TMO) != 0u; const float q = __builtin_nanf("");
        for (int m = gw; m < M; m += NGW) { norm_row_f32(F.out() + (size_t)m * D, F.out() + (size_t)m * D, F.final_g(), F.lane);
            if (bad) { GAS f32x4* o = (GAS f32x4*)(F.out() + (size_t)m * D) + F.lane; o[0] = (f32x4){q, q, q, q}; } }
    }
}

extern "C" void kernel_launch(void* const* d_in, const int* in_sizes, int n_in, void* d_out, int out_size, void* d_ws, size_t ws_size, hipStream_t stream) {
    static int grid = 0;
    if (grid == 0) {
        if (n_in != 22 || in_sizes[0] != M * D || out_size != M * D || ws_size < WS_END) { fprintf(stderr, "kernel_launch: unexpected shapes (n_in %d, in0 %d, out %d, ws %zu); nothing launched\n", n_in, n_in > 0 ? in_sizes[0] : -1, out_size, ws_size); grid = -1; return; }
        int dev = 0, cus = 0, per_cu = 0;
        if (hipGetDevice(&dev) != hipSuccess || hipDeviceGetAttribute(&cus, hipDeviceAttributeMultiprocessorCount, dev) != hipSuccess) { fprintf(stderr, "kernel_launch: device query failed\n"); grid = -1; return; }
        if (hipFuncSetAttribute((const void*)hybrid_block_fwd, hipFuncAttributeMaxDynamicSharedMemorySize, LDS_BYTES) != hipSuccess) { fprintf(stderr, "kernel_launch: hipFuncSetAttribute failed\n"); grid = -1; return; }
        if (hipOccupancyMaxActiveBlocksPerMultiprocessor(&per_cu, (const void*)hybrid_block_fwd, NTHR, LDS_BYTES) != hipSuccess || per_cu < 1)
            fprintf(stderr, "kernel_launch: note: occupancy query reports %d workgroups per CU\n", per_cu);
        (void)hipGetLastError();
        grid = cus;
    }
    if (grid < 0) return;
    if (hipMemsetAsync((char*)d_ws + WS_CTL, 0, CTL_ZERO_BYTES, stream) != hipSuccess) { fprintf(stderr, "kernel_launch: memset failed\n"); return; }
    Args a{};
    for (int i = 0; i < 22; ++i) a.in[i] = (const float*)d_in[i];
    a.out = (float*)d_out; a.ws = (unsigned char*)d_ws;
    hipLaunchKernelGGL(hybrid_block_fwd, dim3(grid), dim3(NTHR), LDS_BYTES, stream, a);
    const hipError_t le = hipPeekAtLastError();
    if (le != hipSuccess) fprintf(stderr, "kernel_launch: launch failed: %s\n", hipGetErrorName(le));
}
```

```cpp
#include <hip/hip_runtime.h>
#include <cstdio>
#include <cstdint>
namespace pg8 {
#define PG8_LAS __attribute__((address_space(3)))
typedef unsigned short bf16_t;
typedef short bf16x8 __attribute__((ext_vector_type(8)));
typedef float f32x4 __attribute__((ext_vector_type(4)));
typedef unsigned u32x4 __attribute__((ext_vector_type(4)));
constexpr int BM = 256, BK = 64, HALF = 128, HTB = HALF * BK * 2  , STAGE_BYTES = 8 * HTB, NXCD = 8;
#ifndef PG8_WGM
#define PG8_WGM 8
#endif
constexpr int WGM = PG8_WGM;

__host__ __device__ __forceinline__ int lds_byte(int r, int c) { const int st = (r >> 4) * 2 + (c >> 5), rr = r & 15, cc = c & 31, ob = rr * 64 + cc * 2; return st * 1024 + (ob ^ (((ob >> 9) & 1) << 5)); }
__host__ __device__ __forceinline__ void stage_rc(int b, int& R, int& C) { const int st = b / 1024, sb = b % 1024, swz = sb ^ (((sb >> 9) & 1) << 5); R = (st >> 1) * 16 + swz / 64; C = (st & 1) * 32 + (swz % 64) / 2; }
__host__ __device__ __forceinline__ int perm32(int rho) { const int n = rho >> 4, i = rho & 15; return 8 * (i >> 2) + 4 * n + (i & 3); }

struct Unit { int pm, pn; };
struct Gemm { const bf16_t* A; const bf16_t* Bt; int M, N, K; };

struct StaticOrder {
    int nM, nN, nwg, G, c, wgm;
    __host__ __device__ void init(int M, int N, int G_, int c_, int wgm_ = WGM) { nM = M / BM; nN = N / BM; nwg = nM * nN; G = G_; c = c_; wgm = wgm_; }
    __host__ __device__ bool next(int i, Unit& u) const {
        const long L = (long)i * G + c; if (L >= nwg) return false;
        int wgid = (int)L; { const int q = nwg / NXCD, r = nwg % NXCD, xcd = wgid % NXCD, off = wgid / NXCD; wgid = (xcd < r ? xcd * (q + 1) : r * (q + 1) + (xcd - r) * q) + off; }
        const int nig = wgm * nN, gid = wgid / nig, fm = gid * wgm, gsz = (nM - fm) < wgm ? (nM - fm) : wgm;
        u.pm = fm + ((wgid % nig) % gsz); u.pn = (wgid % nig) / gsz;
        return true;
    }
    __device__ __forceinline__ void a_ready(const Unit&) const {}
    __device__ __forceinline__ void done(const Unit&) const {}
};


__device__ __forceinline__ unsigned cvt_pk_bf16(float lo, float hi) { unsigned r; asm volatile("v_cvt_pk_bf16_f32 %0, %1, %2" : "=v"(r) : "v"(lo), "v"(hi)); return r; }

constexpr int M_TOK = 16384;
struct EpiBf16Plain {
    static constexpr bool PERM = true, AFTER_DRAIN = false;
    bf16_t* O; int ldc;
    __device__ __forceinline__ void operator()(const f32x4 (&acc)[2][2][4][2], const Unit& u, int wr, int wc, int fr, int fq) const {
        const int row0 = u.pm * BM + wr * 64 + fr, col0 = u.pn * BM + wc * 32 + 8 * fq;
#pragma unroll
        for (int ai = 0; ai < 2; ++ai)
#pragma unroll
            for (int m = 0; m < 4; ++m) { bf16_t* rowp = O + (size_t)(row0 + ai * HALF + m * 16) * ldc + col0;
#pragma unroll
                for (int bj = 0; bj < 2; ++bj) { const f32x4 v0 = acc[ai][bj][m][0], v1 = acc[ai][bj][m][1];
                    u32x4 w; w.x = cvt_pk_bf16(v0[0], v0[1]); w.y = cvt_pk_bf16(v0[2], v0[3]); w.z = cvt_pk_bf16(v1[0], v1[1]); w.w = cvt_pk_bf16(v1[2], v1[3]);
                    *(u32x4*)(rowp + bj * HALF) = w; } }
    }
};
struct EpiProj {
    static constexpr bool PERM = true, AFTER_DRAIN = false;
    bf16_t* O; int seq, nh;
    __device__ __forceinline__ void operator()(const f32x4 (&acc)[2][2][4][2], const Unit& u, int wr, int wc, int fr, int fq) const {
        const int rowp = u.pm * BM, b = rowp / seq, colt = u.pn * BM, which = colt / (nh * 128), head0 = (colt % (nh * 128)) / 128;
        const int t0 = rowp % seq + wr * 64 + fr, d = wc * 32 + 8 * fq;
#pragma unroll
        for (int ai = 0; ai < 2; ++ai)
#pragma unroll
            for (int m = 0; m < 4; ++m) { const int t = t0 + ai * HALF + m * 16; const int rp = which < 2 ? t : ((t & 15) << 8) + (t >> 4);
#pragma unroll
                for (int bj = 0; bj < 2; ++bj) { const f32x4 v0 = acc[ai][bj][m][0], v1 = acc[ai][bj][m][1];
                    u32x4 w; w.x = cvt_pk_bf16(v0[0], v0[1]); w.y = cvt_pk_bf16(v0[2], v0[3]); w.z = cvt_pk_bf16(v1[0], v1[1]); w.w = cvt_pk_bf16(v1[2], v1[3]);
                                        *(u32x4*)(O + ((size_t)((which * (M_TOK / seq) + b) * nh + head0 + bj) * seq + rp) * 128 + d) = w; } }
    }
};
struct EpiResGate {
    static constexpr bool PERM = false, AFTER_DRAIN = false;
    const float* base; float* out; int ldc; const float* gate; int gate_stride; int rows_per_batch;
    __device__ __forceinline__ void operator()(const f32x4 (&acc)[2][2][4][2], const Unit& u, int wr, int wc, int fr, int fq) const {
        const int row0 = u.pm * BM + wr * 64 + fr, col0 = u.pn * BM + wc * 32 + 4 * fq;
        const float* gp = gate + (size_t)((u.pm * BM) / rows_per_batch) * gate_stride + col0;
        f32x4 gv[2][2];
#pragma unroll
        for (int bj = 0; bj < 2; ++bj)
#pragma unroll
            for (int n = 0; n < 2; ++n) gv[bj][n] = *(const f32x4*)(gp + bj * HALF + n * 16);
#pragma unroll
        for (int ai = 0; ai < 2; ++ai)
#pragma unroll
            for (int m = 0; m < 4; ++m) { const size_t off = (size_t)(row0 + ai * HALF + m * 16) * ldc + col0;
#pragma unroll
                for (int bj = 0; bj < 2; ++bj)
#pragma unroll
                    for (int n = 0; n < 2; ++n) { const f32x4 bs = *(const f32x4*)(base + off + bj * HALF + n * 16);
                        *(f32x4*)(out + off + bj * HALF + n * 16) = bs + gv[bj][n] * acc[ai][bj][m][n]; }
                asm volatile("" ::: "memory"); }
    }
};
struct EpiSwiGLU {
    static constexpr bool PERM = true, AFTER_DRAIN = false;
    bf16_t* O; int ldc;
    __device__ __forceinline__ static float silu_mul(float g, float u) { return g * __builtin_amdgcn_rcpf(1.0f + __expf(-g)) * u; }
    __device__ __forceinline__ void operator()(const f32x4 (&acc)[2][2][4][2], const Unit& u, int wr, int wc, int fr, int fq) const {
        const int row0 = u.pm * BM + wr * 64 + fr, col0 = u.pn * HALF + wc * 32 + 8 * fq;
#pragma unroll
        for (int ai = 0; ai < 2; ++ai)
#pragma unroll
            for (int m = 0; m < 4; ++m) { bf16_t* rowp = O + (size_t)(row0 + ai * HALF + m * 16) * ldc + col0;
                const f32x4 g0 = acc[ai][0][m][0], g1 = acc[ai][0][m][1], u0 = acc[ai][1][m][0], u1 = acc[ai][1][m][1];
                u32x4 w;
                w.x = cvt_pk_bf16(silu_mul(g0[0], u0[0]), silu_mul(g0[1], u0[1])); w.y = cvt_pk_bf16(silu_mul(g0[2], u0[2]), silu_mul(g0[3], u0[3]));
                w.z = cvt_pk_bf16(silu_mul(g1[0], u1[0]), silu_mul(g1[1], u1[1])); w.w = cvt_pk_bf16(silu_mul(g1[2], u1[2]), silu_mul(g1[3], u1[3]));
                                *(u32x4*)rowp = w; }
    }
};

template <class Epi, class Sched, bool ALIGN_EPI = false, bool SP2 = false>
__device__ __forceinline__ void gemm_phase(PG8_LAS unsigned char* lds, const Gemm g, const Sched& S, const Epi& E) {
    int tid_ = threadIdx.x; asm volatile("" : "+v"(tid_));
    const int tid = tid_, wid = __builtin_amdgcn_readfirstlane(tid >> 6), lane = tid & 63, wr = wid >> 2, wc = wid & 3, fr = lane & 15, fq = lane >> 4;
    const int K = g.K, nt = K / BK;
    unsigned voffA[2], voffB[2];
#pragma unroll
    for (int i = 0; i < 2; ++i) { int R, C; stage_rc(tid * 16 + i * 8192, R, C); const int Rb = Epi::PERM ? ((R & ~31) + perm32(R & 31)) : R;
        voffA[i] = (unsigned)(R * K + C) * 2u; voffB[i] = (unsigned)(Rb * K + C) * 2u; }
    const size_t kstep = (size_t)(BK * 2);
    const size_t hstep = (size_t)HALF * K * 2;
    const size_t tstep = 2 * hstep;
    const unsigned ldsw = (unsigned)wid * 1024u;
    const int aoff = lds_byte(wr * 64 + fr, fq * 8), boff = lds_byte(wc * 32 + fr, fq * 8);
#define PG8_SA(b, h) (((b) * 2 + (h)) * HTB)
#define PG8_SB(b, h) ((4 + (b) * 2 + (h)) * HTB)
#define PG8_STAGE(bufoff, gbase, voff) do { _Pragma("unroll") for (int _i = 0; _i < 2; ++_i) \
        __builtin_amdgcn_global_load_lds((const unsigned*)((const char*)(gbase) + (voff)[_i]), (PG8_LAS unsigned*)(lds + (bufoff) + ldsw + _i * 8192), 16, 0, 0); } while (0)
#define PG8_LDA(dst, b, h) do { _Pragma("unroll") for (int m = 0; m < 4; ++m) _Pragma("unroll") for (int k = 0; k < 2; ++k) dst[m][k] = *(const PG8_LAS bf16x8*)(lds + PG8_SA(b, h) + aoff + m * 2048 + k * 1024); } while (0)
#define PG8_LDB(dst, b, h) do { _Pragma("unroll") for (int n = 0; n < 2; ++n) _Pragma("unroll") for (int k = 0; k < 2; ++k) dst[n][k] = *(const PG8_LAS bf16x8*)(lds + PG8_SB(b, h) + boff + n * 2048 + k * 1024); } while (0)
#define PG8_MMA(ai, bj, At, Bt) do { __builtin_amdgcn_s_setprio(1); _Pragma("unroll") for (int m = 0; m < 4; ++m) _Pragma("unroll") for (int n = 0; n < 2; ++n) _Pragma("unroll") for (int k = 0; k < 2; ++k) \
        acc[ai][bj][m][n] = __builtin_amdgcn_mfma_f32_16x16x32_bf16(Bt[n][k], At[m][k], acc[ai][bj][m][n], 0, 0, 0); __builtin_amdgcn_s_setprio(0); } while (0)
#define PG8_WAIT_V(n) asm volatile("s_waitcnt vmcnt(" #n ")" ::: "memory")
#define PG8_WAIT_L(n) asm volatile("s_waitcnt lgkmcnt(" #n ")" ::: "memory")
#define PG8_BAR __builtin_amdgcn_s_barrier()
#define PG8_SCHED __builtin_amdgcn_sched_barrier(0)
    Unit cur, nxt; int ui = 0;
    if (!S.next(0, cur)) return;
    f32x4 acc[2][2][4][2];
#pragma unroll
    for (int a = 0; a < 2; ++a)
#pragma unroll
        for (int b = 0; b < 2; ++b)
#pragma unroll
            for (int m = 0; m < 4; ++m)
#pragma unroll
                for (int n = 0; n < 2; ++n) acc[a][b][m][n] = (f32x4){0.f, 0.f, 0.f, 0.f};
    bf16x8 At[4][2], B0[2][2], B1[2][2];
    const char* cA = (const char*)g.A + (size_t)cur.pm * tstep; const char* cB = (const char*)g.Bt + (size_t)cur.pn * tstep;
    S.a_ready(cur);
    if constexpr (SP2) {
        PG8_STAGE(PG8_SB(0, 0), cB, voffB); PG8_STAGE(PG8_SB(0, 1), cB + hstep, voffB); PG8_STAGE(PG8_SA(0, 0), cA, voffA); PG8_STAGE(PG8_SA(0, 1), cA + hstep, voffA);
        if (wr == 1) PG8_BAR;
        PG8_WAIT_V(2); PG8_BAR;
        PG8_STAGE(PG8_SB(1, 0), cB + kstep, voffB); PG8_STAGE(PG8_SA(1, 0), cA + kstep, voffA); PG8_STAGE(PG8_SB(1, 1), cB + hstep + kstep, voffB);
        PG8_WAIT_V(6); PG8_BAR;
    } else {
        PG8_STAGE(PG8_SB(0, 0), cB, voffB); PG8_STAGE(PG8_SA(0, 0), cA, voffA); PG8_STAGE(PG8_SB(0, 1), cB + hstep, voffB); PG8_STAGE(PG8_SA(0, 1), cA + hstep, voffA);
        if (wr == 1) PG8_BAR;
        PG8_WAIT_V(4); PG8_BAR;
        PG8_STAGE(PG8_SB(1, 0), cB + kstep, voffB); PG8_STAGE(PG8_SA(1, 0), cA + kstep, voffA); PG8_STAGE(PG8_SB(1, 1), cB + hstep + kstep, voffB);
        PG8_WAIT_V(6); PG8_BAR;
    }
    for (;;) {
        const bool has_next = S.next(ui + 1, nxt);
        const char* nA = has_next ? (const char*)g.A + (size_t)nxt.pm * tstep : cA; const char* nB = has_next ? (const char*)g.Bt + (size_t)nxt.pn * tstep : cB;
        for (int t = 0; t < nt; t += 2) {
            const bool last = (t == nt - 2);
            const char* a1 = cA + (size_t)(t + 1) * kstep;
            const char* a2 = last ? nA : cA + (size_t)(t + 2) * kstep; const char* b2 = last ? nB : cB + (size_t)(t + 2) * kstep;
            const char* a3 = a2 + kstep; const char* b3 = b2 + kstep;
            if (last && has_next) S.a_ready(nxt);
            if constexpr (SP2) {
            PG8_LDB(B0, 0, 0); PG8_LDB(B1, 0, 1); PG8_SCHED; PG8_LDA(At, 0, 0); PG8_STAGE(PG8_SA(1, 1), a1 + hstep, voffA);
            PG8_WAIT_V(8); PG8_WAIT_L(0); PG8_BAR; PG8_MMA(0, 0, At, B0); PG8_MMA(0, 1, At, B1); PG8_BAR; PG8_SCHED;
            PG8_LDA(At, 0, 1); PG8_STAGE(PG8_SB(0, 0), b2, voffB); PG8_STAGE(PG8_SB(0, 1), b2 + hstep, voffB); PG8_STAGE(PG8_SA(0, 0), a2, voffA);
            PG8_WAIT_V(8); PG8_WAIT_L(0); PG8_BAR; PG8_MMA(1, 0, At, B0); PG8_MMA(1, 1, At, B1); PG8_BAR; PG8_SCHED;
            PG8_LDB(B0, 1, 0); PG8_LDB(B1, 1, 1); PG8_SCHED; PG8_LDA(At, 1, 0); PG8_STAGE(PG8_SA(0, 1), a2 + hstep, voffA);
            PG8_WAIT_V(8); PG8_WAIT_L(0); PG8_BAR; PG8_MMA(0, 0, At, B0); PG8_MMA(0, 1, At, B1); PG8_BAR; PG8_SCHED;
            PG8_LDA(At, 1, 1); PG8_STAGE(PG8_SB(1, 0), b3, voffB); PG8_STAGE(PG8_SB(1, 1), b3 + hstep, voffB); PG8_STAGE(PG8_SA(1, 0), a3, voffA);
            PG8_WAIT_V(8); PG8_WAIT_L(0); PG8_BAR; PG8_MMA(1, 0, At, B0); PG8_MMA(1, 1, At, B1); PG8_BAR; PG8_SCHED;
            } else {
            PG8_LDB(B0, 0, 0); PG8_SCHED; PG8_LDA(At, 0, 0); PG8_STAGE(PG8_SA(1, 1), a1 + hstep, voffA);
            PG8_WAIT_L(8); PG8_BAR; PG8_WAIT_L(0); PG8_MMA(0, 0, At, B0); PG8_BAR; PG8_SCHED;
            PG8_LDB(B1, 0, 1); PG8_STAGE(PG8_SB(0, 0), b2, voffB);
            PG8_BAR; PG8_WAIT_L(0); PG8_MMA(0, 1, At, B1); PG8_BAR;
            PG8_LDA(At, 0, 1); PG8_STAGE(PG8_SA(0, 0), a2, voffA);
            PG8_BAR; PG8_WAIT_L(0); PG8_MMA(1, 0, At, B0); PG8_BAR; PG8_SCHED;
            PG8_STAGE(PG8_SB(0, 1), b2 + hstep, voffB);
            PG8_WAIT_V(6); PG8_BAR; PG8_MMA(1, 1, At, B1); PG8_BAR;
            PG8_LDB(B0, 1, 0); PG8_SCHED; PG8_LDA(At, 1, 0); PG8_STAGE(PG8_SA(0, 1), a2 + hstep, voffA);
            PG8_WAIT_L(8); PG8_BAR; PG8_WAIT_L(0); PG8_MMA(0, 0, At, B0); PG8_BAR; PG8_SCHED;
            PG8_LDB(B1, 1, 1); PG8_STAGE(PG8_SB(1, 0), b3, voffB);
            PG8_BAR; PG8_WAIT_L(0); PG8_MMA(0, 1, At, B1); PG8_BAR;
            PG8_LDA(At, 1, 1); PG8_STAGE(PG8_SA(1, 0), a3, voffA);
            PG8_BAR; PG8_WAIT_L(0); PG8_MMA(1, 0, At, B0); PG8_BAR; PG8_SCHED;
            PG8_STAGE(PG8_SB(1, 1), b3 + hstep, voffB);
            PG8_WAIT_V(6); PG8_BAR; PG8_MMA(1, 1, At, B1); PG8_BAR;
            }
        }
        if constexpr (ALIGN_EPI) { if (wr == 0) PG8_BAR; }
        if constexpr (!Epi::AFTER_DRAIN) { E(acc, cur, wr, wc, fr, fq); S.done(cur); }
        if (!has_next) break;
#pragma unroll
        for (int a = 0; a < 2; ++a)
#pragma unroll
            for (int b = 0; b < 2; ++b)
#pragma unroll
                for (int m = 0; m < 4; ++m)
#pragma unroll
                    for (int n = 0; n < 2; ++n) acc[a][b][m][n] = (f32x4){0.f, 0.f, 0.f, 0.f};
        cur = nxt; cA = nA; cB = nB; ++ui;
        if constexpr (ALIGN_EPI) { if (wr == 1) PG8_BAR; }
    }
    PG8_WAIT_V(0);
    if constexpr (!ALIGN_EPI) { if (wr == 0) PG8_BAR; }
    PG8_BAR;
    if constexpr (Epi::AFTER_DRAIN) { E.fused(acc, cur, wr, wc, fr, fq, lds, wid, lane); S.done(cur); }
#undef PG8_SA
#undef PG8_SB
#undef PG8_STAGE
#undef PG8_LDA
#undef PG8_LDB
#undef PG8_MMA
#undef PG8_WAIT_V
#undef PG8_WAIT_L
#undef PG8_BAR
#undef PG8_SCHED
}
}

#ifndef PG8_SP2
#define PG8_SP2 true
#endif
#ifndef PG8_ALIGN
#define PG8_ALIGN true
#endif

constexpr int NWAVES = 8, NTHR = 512;
constexpr int BATCH = 4, SEQ = 4096, D = 4096, M = BATCH * SEQ, RW = 2048, AW = 2048, HD = 128, NH = 16;
constexpr int NPROJ = 10240, DFF = 11008, NGU = 2 * DFF, NADA = 6 * D;
constexpr int T_XR = 0, T_YG = 1, T_Q = 2, T_K = 3, T_V = 4;
__host__ __device__ constexpr size_t proj_base(int which, int b, int h) { return ((size_t)((which * BATCH + b) * NH + h) * SEQ) * 128; }
__host__ __device__ constexpr int tpos(int t) { return ((t & 15) << 8) + (t >> 4); }
constexpr float EPS = 1e-6f;
constexpr int RG_TC = 64, RG_NCH = SEQ / RG_TC;
constexpr int ADA_KS = 8, ADA_KCH = D / ADA_KS;
constexpr size_t MiB = 1u << 20;
constexpr size_t WS_CTL = 0, CTL_ZERO_BYTES = 1 * MiB;
constexpr size_t WS_MOD = 1 * MiB, WS_BIAS = 2 * MiB, WS_WAT = 3 * MiB, WS_WIT = 4 * MiB, WS_MODP = 5 * MiB, WS_AGG = 8 * MiB, WS_LSE = 12 * MiB;
constexpr size_t WS_WIN = 16 * MiB, WS_WOUT = 96 * MiB, WS_WGU = 128 * MiB, WS_WDN = 300 * MiB, WS_HB = 386 * MiB;
constexpr size_t WS_PROJ = 514 * MiB, WS_REC = 834 * MiB, WS_OP = 898 * MiB, WS_X1 = 1090 * MiB, WS_HB2 = 1346 * MiB, WS_END = 1474 * MiB;
constexpr size_t WS_U = 514 * MiB;
static_assert(WS_WIN + (size_t)NPROJ * D * 2 <= WS_WOUT && WS_WOUT + (size_t)D * D * 2 <= WS_WGU && WS_WGU + (size_t)NGU * D * 2 <= WS_WDN && WS_WDN + (size_t)D * DFF * 2 <= WS_HB, "ws map 1");
static_assert(WS_HB + (size_t)M * D * 2 <= WS_PROJ && WS_PROJ + (size_t)M * NPROJ * 2 <= WS_REC && WS_REC + (size_t)M * RW * 2 <= WS_OP && WS_OP + (size_t)3 * M * AW * 2 <= WS_X1 && WS_X1 + (size_t)M * D * 4 <= WS_END, "ws map 2");
static_assert(WS_U + (size_t)M * DFF * 2 <= WS_X1 && WS_HB2 + (size_t)M * D * 2 <= WS_END, "ws map 3");
static_assert(WS_MODP + (size_t)ADA_KS * BATCH * NADA * 4 <= WS_AGG && WS_AGG + (size_t)BATCH * NH * RG_NCH * 256 * 4 <= WS_LSE && WS_LSE + (size_t)3 * M * NH * 4 <= WS_WIN, "ws map 4");
constexpr int CW_BAR = 4096;
constexpr size_t WS_SSQ2 = 192 * 1024;
static_assert(WS_SSQ2 + (size_t)M * 4 <= CTL_ZERO_BYTES, "ctl map 2");
constexpr size_t WS_PCNT = 64 * 1024;
static_assert((CW_BAR + 3456) * 4 <= WS_PCNT && WS_PCNT + 2 * 64 * 256 <= 128 * 1024, "ctl map 3");
constexpr size_t WS_SSQ3 = 128 * 1024;
static_assert((CW_BAR + 3456) * 4 <= WS_SSQ3 && WS_SSQ3 + (size_t)M * 4 <= CTL_ZERO_BYTES, "ctl map");
constexpr int LDS_BYTES = 147456;
constexpr int MISC_OFF = 147456 - 256;
constexpr int ATT_PITCH = 272, ATT_KS = 0, ATT_VS = 256 * ATT_PITCH, ATT_BS = 2 * 256 * ATT_PITCH;
static_assert(ATT_BS + 160 * 4 <= MISC_OFF, "attention LDS");
constexpr int RG_XB = 0, RG_XF = RG_TC * 272, RG_AS = RG_XF + RG_TC * 128 * 4, RG_US = RG_AS + RG_TC * 128 * 4, RG_SUB = RG_US + RG_TC * 128 * 4, RG_YG = RG_SUB + 2 * 4 * 128 * 4;
static_assert(RG_YG + RG_TC * 256 <= MISC_OFF && (RG_TC + 3) * 256 <= RG_TC * 128 * 4 && RG_TC * 256 <= RG_TC * 272, "rg LDS");
constexpr int RG_SPAN = 16, RG_NSPAN = BATCH * NH * (RG_NCH / RG_SPAN);

#define GAS __attribute__((address_space(1)))
#define LAS __attribute__((address_space(3)))
typedef unsigned short bf16;
typedef unsigned v4u __attribute__((ext_vector_type(4)));
typedef unsigned v2u __attribute__((ext_vector_type(2)));
typedef float f32x4 __attribute__((ext_vector_type(4)));
typedef short bf16x8 __attribute__((ext_vector_type(8)));
typedef short s16x4 __attribute__((ext_vector_type(4)));
typedef GAS unsigned gu32;
#define LDS_WAIT() asm volatile("s_waitcnt lgkmcnt(0)" ::: "memory")
#define VM_WAIT() asm volatile("s_waitcnt vmcnt(0)" ::: "memory")
__device__ __forceinline__ unsigned f2bf(float f) { unsigned u = __builtin_bit_cast(unsigned, f); return (u + 0x7fffu + ((u >> 16) & 1u)) >> 16; }
__device__ __forceinline__ unsigned pk2(float lo, float hi) { unsigned r; asm("v_cvt_pk_bf16_f32 %0, %1, %2" : "=v"(r) : "v"(lo), "v"(hi)); return r; }
__device__ __forceinline__ float bf_lo(unsigned w) { return __builtin_bit_cast(float, w << 16); }
__device__ __forceinline__ float bf_hi(unsigned w) { return __builtin_bit_cast(float, w & 0xffff0000u); }
__device__ __forceinline__ float wave_sum(float v) {
#pragma unroll
    for (int o = 1; o < 64; o <<= 1) v += __shfl_xor(v, o);
    return v;
}
__device__ __forceinline__ float sigmoidf_(float x) { return __builtin_amdgcn_rcpf(1.0f + __expf(-x)); }
__device__ __forceinline__ float gelu_tanh(float x) {
    constexpr float c0 = (float)(-2.0 * 0.7978845608028654 * 1.4426950408889634), c1 = (float)(-2.0 * 0.7978845608028654 * 0.044715 * 1.4426950408889634);
    const float t = x * x; return x * __builtin_amdgcn_rcpf(1.0f + __builtin_amdgcn_exp2f(x * __builtin_fmaf(t, c1, c0))); }

#define XB_TMO      128
#define XB_XCNT(j)  (256  + 64 * (j))
#define XB_XSUB(j)  (1280 + 64 * (j))
#define XB_XGEN(j)  (2304 + 64 * (j))
#define XB_TOP      3328
#define XB_TOPGEN   3392
#define XCD_BAR_WORDS 3456
#define XB_SPIN_CAP (1u << 18)

__device__ __forceinline__ unsigned xb_ld(unsigned* p)              { return __hip_atomic_load(p, __ATOMIC_RELAXED, __HIP_MEMORY_SCOPE_AGENT); }
__device__ __forceinline__ unsigned xb_add(unsigned* p, unsigned v) { return __hip_atomic_fetch_add(p, v, __ATOMIC_RELAXED, __HIP_MEMORY_SCOPE_AGENT); }
__device__ __forceinline__ unsigned xb_xcc_id() { return (unsigned)__builtin_amdgcn_s_getreg((3 << 11) | 20) & 0xFu; }
#define XB_SPIN(cond, bar) do { unsigned _sp = 0; while (cond) { __builtin_amdgcn_s_sleep(1); \
    if ((++_sp & 255u) == 0u) { if (xb_ld(&(bar)[XB_TMO])) break; if (_sp > XB_SPIN_CAP) { atomicAdd(&(bar)[XB_TMO], 1u); break; } } } } while (0)

struct XcdBarrier {
    unsigned* bar; unsigned x;
    volatile LAS unsigned* st;
};

__device__ __forceinline__ XcdBarrier xcd_barrier_post(unsigned* bar, volatile LAS unsigned* st) {
    XcdBarrier b; b.bar = bar; b.x = xb_xcc_id(); b.st = st;
    if (threadIdx.x == 0) (void)xb_add(&bar[XB_XCNT(b.x)], 1u);
    return b;
}
__device__ __forceinline__ void xcd_barrier_complete(unsigned* bar, unsigned x, unsigned& nloc, unsigned& nx) {
    const unsigned G = gridDim.x * gridDim.y * gridDim.z;
    unsigned sum, cnt, mine, sp = 0u;
    for (;;) {
        sum = 0u; cnt = 0u; mine = 0u;
#pragma unroll
        for (unsigned j = 0; j < 16; ++j) { const unsigned c = xb_ld(&bar[XB_XCNT(j)]); sum += c; cnt += (c > 0u) ? 1u : 0u; mine = (j == x) ? c : mine; }
        if (sum == G) break;
        __builtin_amdgcn_s_sleep(1);
        if ((++sp & 255u) == 0u) { if (xb_ld(&bar[XB_TMO])) break; if (sp > XB_SPIN_CAP) { atomicAdd(&bar[XB_TMO], 1u); break; } }
    }
    nloc = mine > 0u ? mine : 1u; nx = cnt > 0u ? cnt : 1u;
}

__device__ __forceinline__ void xcd_barrier(const XcdBarrier& b) {
    asm volatile("s_waitcnt vmcnt(0)" ::: "memory");
    __syncthreads();
    if (threadIdx.x == 0) {
        unsigned* bar = b.bar;
        __builtin_amdgcn_s_waitcnt(0);
        unsigned nloc = b.st[0], nx = b.st[1];
        if (nloc == 0u) { xcd_barrier_complete(bar, b.x, nloc, nx); b.st[0] = nloc; b.st[1] = nx; }
        const unsigned old = xb_add(&bar[XB_XSUB(b.x)], 1u);
        const unsigned gen = old / nloc;
        if (old + 1u == (gen + 1u) * nloc) {
            __builtin_amdgcn_fence(__ATOMIC_RELEASE, "agent");
            asm volatile("s_waitcnt vmcnt(0)" ::: "memory");
            const unsigned og = xb_add(&bar[XB_TOP], 1u);
            const unsigned tg = og / nx;
            if (og + 1u == (tg + 1u) * nx) xb_add(&bar[XB_TOPGEN], 1u);
            else XB_SPIN(xb_ld(&bar[XB_TOPGEN]) == tg, bar);
            __builtin_amdgcn_fence(__ATOMIC_ACQUIRE, "agent");
            xb_add(&bar[XB_XGEN(b.x)], 1u);
            asm volatile("s_waitcnt vmcnt(0)" ::: "memory");
        } else {
            XB_SPIN(xb_ld(&bar[XB_XGEN(b.x)]) == gen, bar);
            __builtin_amdgcn_fence(__ATOMIC_ACQUIRE, "agent");
            asm volatile("s_waitcnt vmcnt(0)" ::: "memory");
        }
    }
    __syncthreads();
}

struct KArgs { const float* in[22]; float* out; unsigned char* ws; };
typedef const __attribute__((address_space(4))) KArgs* KArgsP;
__device__ __forceinline__ KArgsP kargs() { KArgsP p = (KArgsP)__builtin_amdgcn_kernarg_segment_ptr(); asm volatile("" : "+s"(p)); return p; }
struct Frame {
    LAS unsigned char* lds;
    volatile LAS unsigned* MISC;
    gu32* ctl;
    int tid, lane, wave;
    int vcu, G;
    KArgsP A;
    __device__ __forceinline__ const float* x() const { return A->in[0]; }
    __device__ __forceinline__ const float* c() const { return A->in[1]; }
    __device__ __forceinline__ const float* ada_w() const { return A->in[2]; }
    __device__ __forceinline__ const float* ada_b() const { return A->in[3]; }
    __device__ __forceinline__ const float* norm1_g() const { return A->in[4]; }
    __device__ __forceinline__ const float* norm2_g() const { return A->in[5]; }
    __device__ __forceinline__ const float* w_in() const { return A->in[6]; }
    __device__ __forceinline__ const float* conv_w() const { return A->in[7]; }
    __device__ __forceinline__ const float* conv_b() const { return A->in[8]; }
    __device__ __forceinline__ const float* rg_w_a() const { return A->in[9]; }
    __device__ __forceinline__ const float* rg_b_a() const { return A->in[10]; }
    __device__ __forceinline__ const float* rg_w_i() const { return A->in[11]; }
    __device__ __forceinline__ const float* rg_b_i() const { return A->in[12]; }
    __device__ __forceinline__ const float* lam() const { return A->in[13]; }
    __device__ __forceinline__ const float* rel_bias() const { return A->in[14]; }
    __device__ __forceinline__ const float* gn_rec() const { return A->in[15]; }
    __device__ __forceinline__ const float* gn_att() const { return A->in[16]; }
    __device__ __forceinline__ const float* w_out() const { return A->in[17]; }
    __device__ __forceinline__ const float* w_gate() const { return A->in[18]; }
    __device__ __forceinline__ const float* w_up() const { return A->in[19]; }
    __device__ __forceinline__ const float* w_down() const { return A->in[20]; }
    __device__ __forceinline__ const float* final_g() const { return A->in[21]; }
    __device__ __forceinline__ float* out() const { return A->out; }
    __device__ __forceinline__ bf16* PG() const { return (bf16*)(A->ws + WS_REC); }
    __device__ __forceinline__ float* SSQ3() const { return (float*)(A->ws + WS_SSQ3); }
    __device__ __forceinline__ unsigned* PCNT(int bank) const { return (unsigned*)(A->ws + WS_PCNT) + bank * 64 * 64; }
    __device__ __forceinline__ float* SSQ2() const { return (float*)(A->ws + WS_SSQ2); }
    __device__ __forceinline__ bf16* HB2() const { return (bf16*)(A->ws + WS_HB2); }
    __device__ __forceinline__ float* MOD() const { return (float*)(A->ws + WS_MOD); }
    __device__ __forceinline__ float* BIAS() const { return (float*)(A->ws + WS_BIAS); }
    __device__ __forceinline__ float* MODP() const { return (float*)(A->ws + WS_MODP); }
    __device__ __forceinline__ float* AGG() const { return (float*)(A->ws + WS_AGG); }
    __device__ __forceinline__ float* LSE() const { return (float*)(A->ws + WS_LSE); }
    __device__ __forceinline__ float* X1() const { return (float*)(A->ws + WS_X1); }
    __device__ __forceinline__ bf16* WAT() const { return (bf16*)(A->ws + WS_WAT); }
    __device__ __forceinline__ bf16* WIT() const { return (bf16*)(A->ws + WS_WIT); }
    __device__ __forceinline__ bf16* WIN() const { return (bf16*)(A->ws + WS_WIN); }
    __device__ __forceinline__ bf16* WOUT() const { return (bf16*)(A->ws + WS_WOUT); }
    __device__ __forceinline__ bf16* WGU() const { return (bf16*)(A->ws + WS_WGU); }
    __device__ __forceinline__ bf16* WDN() const { return (bf16*)(A->ws + WS_WDN); }
    __device__ __forceinline__ bf16* HB() const { return (bf16*)(A->ws + WS_HB); }
    __device__ __forceinline__ bf16* PROJ() const { return (bf16*)(A->ws + WS_PROJ); }
    __device__ __forceinline__ bf16* REC() const { return (bf16*)(A->ws + WS_REC); }
    __device__ __forceinline__ bf16* OP() const { return (bf16*)(A->ws + WS_OP); }
    __device__ __forceinline__ bf16* U() const { return (bf16*)(A->ws + WS_U); }
};

__device__ __forceinline__ void tr_item(const float* W, int N, bf16* WT, int Kp, int k0, int n0, int drow0, LAS float* scr, int lane) {
    { const GAS float* src = (const GAS float*)W + (size_t)(k0 + (lane >> 3)) * N + n0 + (lane & 7) * 4;
      LAS float* dst = scr + (lane >> 3) * 33 + (lane & 7) * 4; const size_t rs8 = (size_t)8 * N;
      f32x4 v[8];
#pragma unroll
      for (int i = 0; i < 8; ++i) v[i] = *(const GAS f32x4*)(src + i * rs8);
#pragma unroll
      for (int i = 0; i < 8; ++i) { dst[i * 8 * 33 + 0] = v[i].x; dst[i * 8 * 33 + 1] = v[i].y; dst[i * 8 * 33 + 2] = v[i].z; dst[i * 8 * 33 + 3] = v[i].w; } }
    LDS_WAIT(); asm volatile("" ::: "memory");
    const int c = lane & 7;
#pragma unroll
    for (int j = 0; j < 4; ++j) { const int n = (lane >> 3) + 8 * j; const LAS float* s = scr + (8 * c) * 33 + n;
        v4u o; o.x = pk2(s[0 * 33], s[1 * 33]); o.y = pk2(s[2 * 33], s[3 * 33]); o.z = pk2(s[4 * 33], s[5 * 33]); o.w = pk2(s[6 * 33], s[7 * 33]);
        *(GAS v4u*)(WT + (size_t)(drow0 + n) * Kp + k0 + 8 * c) = o; }
    LDS_WAIT(); asm volatile("" ::: "memory");
}
constexpr int TR_IN = (D / 64) * (NPROJ / 32), TR_OUT = (D / 64) * (D / 32), TR_G = (D / 64) * (DFF / 32), TR_DN = (DFF / 64) * (D / 32), TR_RG = NH * 2 * 4;
constexpr int TR_TOTAL = TR_IN + TR_OUT + 2 * TR_G + 2 * TR_RG;
__device__ __forceinline__ void tr_dispatch(Frame& F, int it, LAS float* scr) {
    int r = it;
    if (r < TR_IN) { const int nnb = NPROJ / 32, kb = r / nnb, nb = r % nnb; tr_item(F.w_in(), NPROJ, F.WIN(), D, 64 * kb, 32 * nb, 32 * nb, scr, F.lane); return; } r -= TR_IN;
    if (r < TR_OUT) { const int nnb = D / 32, kb = r / nnb, nb = r % nnb; tr_item(F.w_out(), D, F.WOUT(), D, 64 * kb, 32 * nb, 32 * nb, scr, F.lane); return; } r -= TR_OUT;
    if (r < TR_G) { const int nnb = DFF / 32, kb = r / nnb, nb = r % nnb, n0 = 32 * nb; tr_item(F.w_gate(), DFF, F.WGU(), D, 64 * kb, n0, 256 * (n0 >> 7) + (n0 & 127), scr, F.lane); return; } r -= TR_G;
    if (r < TR_G) { const int nnb = DFF / 32, kb = r / nnb, nb = r % nnb, n0 = 32 * nb; tr_item(F.w_up(), DFF, F.WGU(), D, 64 * kb, n0, 256 * (n0 >> 7) + 128 + (n0 & 127), scr, F.lane); return; } r -= TR_G;
    if (r < TR_RG) { const int hh = r >> 3, kb = (r >> 2) & 1, nb = r & 3; tr_item(F.rg_w_a() + hh * 16384, 128, F.WAT() + hh * 16384, 128, 64 * kb, 32 * nb, 32 * nb, scr, F.lane); return; } r -= TR_RG;
    { const int hh = r >> 3, kb = (r >> 2) & 1, nb = r & 3; tr_item(F.rg_w_i() + hh * 16384, 128, F.WIT() + hh * 16384, 128, 64 * kb, 32 * nb, 32 * nb, scr, F.lane); }
}
__device__ __forceinline__ void ada_item(Frame& F, int cg, int ks, LAS float* scr) {
    const int kbase = ADA_KCH * ks;
#pragma unroll
    for (int j = 0; j < ADA_KCH / 64; ++j) { const int kk = F.lane + 64 * j;
#pragma unroll
        for (int b = 0; b < BATCH; ++b) { const float cv = F.c()[(size_t)b * D + kbase + kk]; scr[kk * 4 + b] = cv * sigmoidf_(cv); } }
    LDS_WAIT(); asm volatile("" ::: "memory");
    const int col = 256 * cg + 4 * F.lane;
    const float* wp = F.ada_w() + (size_t)kbase * NADA + col;
    f32x4 a0 = {0.f, 0.f, 0.f, 0.f}, a1 = a0, a2 = a0, a3 = a0;
#pragma unroll 8
    for (int k = 0; k < ADA_KCH; ++k) { const f32x4 w = *(const GAS f32x4*)(wp + (size_t)k * NADA); const f32x4 cv = *(const LAS f32x4*)(scr + 4 * k);
        a0 += cv.x * w; a1 += cv.y * w; a2 += cv.z * w; a3 += cv.w * w; }
    float* o = F.MODP() + (size_t)(ks * BATCH) * NADA + col;
    *(GAS f32x4*)(o) = a0; *(GAS f32x4*)(o + NADA) = a1; *(GAS f32x4*)(o + 2 * NADA) = a2; *(GAS f32x4*)(o + 3 * NADA) = a3;
    LDS_WAIT(); asm volatile("" ::: "memory");
}
__device__ __forceinline__ int t5_bucket(int n) {
    if (n < 16) return n;
    const float nf = (float)n;
    int large = 16 + (int)(logf(nf / 16.0f) / 4.852030263919617f * 16.0f);
    return large < 31 ? large : 31;
}
__device__ __forceinline__ void p0_prologue(Frame& F) {
    LAS float* scr = (LAS float*)(F.lds + F.wave * 16384);
    const int gw = F.vcu * NWAVES + F.wave, NGW = F.G * NWAVES;
    const int n_ada = (NADA / 256) * ADA_KS, n_adaw = F.G * 3;
    if (F.wave < 3) for (int it = F.vcu * 3 + F.wave; it < n_ada; it += n_adaw) ada_item(F, it % (NADA / 256), it / (NADA / 256), scr);
    const int NA = 9 * NGW < TR_TOTAL ? 9 * NGW : TR_TOTAL;
    for (int it = gw; it < NA; it += NGW) tr_dispatch(F, it, scr);
    if (F.wave >= 3) { const int gw2 = F.vcu * 5 + (F.wave - 3), NGW2 = F.G * 5;
        for (int it = NA + gw2; it < TR_TOTAL; it += NGW2) tr_dispatch(F, it, scr); }
    if (F.vcu == 0) for (int i = F.tid; i < 3 * 129 * NH; i += NTHR) { const int h = i % NH, dist = (i / NH) % 129, p = i / (NH * 129); F.BIAS()[i] = F.rel_bias()[t5_bucket(dist << (2 * p)) * NH + h]; }
}
__device__ __forceinline__ void tr_down_tail(Frame& F, int rank, int nw_cu) {
    LAS float* scr = (LAS float*)(F.lds + F.wave * 16384);
    for (int it = rank * NWAVES + F.wave; it < TR_DN; it += nw_cu * NWAVES) { const int nnb = D / 32, kb = it / nnb, nb = it % nnb;
        tr_item(F.w_down(), D, F.WDN(), DFF, 64 * kb, 32 * nb, 32 * nb, scr, F.lane); }
}
__device__ __forceinline__ void norm_mod_row(const float* xrow, bf16* orow, const float* g, const float* sc, const float* sh, int lane) {
    const GAS f32x4* xr = (const GAS f32x4*)xrow + lane;
    f32x4 v[16]; float s = 0.f;
#pragma unroll
    for (int j = 0; j < 16; ++j) { v[j] = xr[64 * j]; s += (v[j].x * v[j].x + v[j].y * v[j].y) + (v[j].z * v[j].z + v[j].w * v[j].w); }
    const float rs = __builtin_amdgcn_rsqf(wave_sum(s) * (1.0f / D) + EPS);
    GAS v2u* o8 = (GAS v2u*)orow + lane;
#pragma unroll
    for (int j = 0; j < 16; ++j) { const int cidx = lane + 64 * j;
        const f32x4 gv = ((const GAS f32x4*)g)[cidx], scv = ((const GAS f32x4*)sc)[cidx], shv = ((const GAS f32x4*)sh)[cidx];
        const f32x4 h = v[j] * rs * gv * (1.0f + scv) + shv;
        v2u w; w.x = pk2(h.x, h.y); w.y = pk2(h.z, h.w); o8[64 * j] = w; }
}
__device__ __forceinline__ void norm_row_f32(const float* xrow, float* orow, const float* g, int lane) {
    const GAS f32x4* xr = (const GAS f32x4*)xrow + lane;
    f32x4 v[16]; float s = 0.f;
#pragma unroll
    for (int j = 0; j < 16; ++j) { v[j] = xr[64 * j]; s += (v[j].x * v[j].x + v[j].y * v[j].y) + (v[j].z * v[j].z + v[j].w * v[j].w); }
    const float rs = __builtin_amdgcn_rsqf(wave_sum(s) * (1.0f / D) + EPS);
    GAS f32x4* o = (GAS f32x4*)orow + lane;
#pragma unroll
    for (int j = 0; j < 16; ++j) { const f32x4 gv = ((const GAS f32x4*)g)[lane + 64 * j]; o[64 * j] = v[j] * rs * gv; }
}

__device__ __forceinline__ void panel_arrive_wait(unsigned* cnt, unsigned want, unsigned* tmo, int wid, int lane) {
    asm volatile("s_waitcnt vmcnt(0)" ::: "memory");
    if (lane == 0) (void)__hip_atomic_fetch_add(cnt, 1u, __ATOMIC_RELAXED, __HIP_MEMORY_SCOPE_AGENT);
    if (wid == 0) { unsigned sp = 0;
        while ((unsigned)__builtin_amdgcn_readfirstlane(__hip_atomic_load(cnt, __ATOMIC_RELAXED, __HIP_MEMORY_SCOPE_AGENT)) < want) {
            __builtin_amdgcn_s_sleep(2);
            if ((++sp & 255u) == 0u) { if (xb_ld(tmo)) break; if (sp > (1u << 20)) { if (lane == 0) atomicAdd(tmo, 1u); break; } } }
        __builtin_amdgcn_fence(__ATOMIC_ACQUIRE, "agent"); }
    asm volatile("s_waitcnt vmcnt(0) lgkmcnt(0)" ::: "memory");
    __syncthreads();
}
struct OneUnitOrder {
    pg8::StaticOrder S; int r;
    __device__ bool next(int i, pg8::Unit& u) const { return i == 0 && S.next(r, u); }
    __device__ __forceinline__ void a_ready(const pg8::Unit&) const {}
    __device__ __forceinline__ void done(const pg8::Unit&) const {}
};
struct PanelRoundOrder {
    int c, rounds;
    __device__ bool next(int i, pg8::Unit& u) const { if (i >= rounds) return false; const int x = c & 7, k = c >> 3; u.pm = 16 * i + 4 * (x >> 1) + (k & 3); u.pn = 8 * (x & 1) + (k >> 2); return true; }
    __device__ __forceinline__ void a_ready(const pg8::Unit&) const {}
    __device__ __forceinline__ void done(const pg8::Unit&) const {}
};
struct EpiFinalNorm {
    static constexpr bool PERM = false, AFTER_DRAIN = false;
    __device__ __forceinline__ void operator()(pg8::f32x4 (&acc)[2][2][4][2], const pg8::Unit& u, int wr, int wc, int fr, int fq) const { fused(acc, u, wr, wc, fr, fq, nullptr, wr * 4 + wc, fq * 16 + fr); }
    const float* base; float* out; int ldc; const float* gate; int gate_stride; int rows_per_batch; float* ssq; const float* fg; const XcdBarrier* bar; unsigned* cnt; float inv_d, eps;
    __device__ __forceinline__ void fused(pg8::f32x4 (&acc)[2][2][4][2], const pg8::Unit& u, int wr, int wc, int fr, int fq, PG8_LAS unsigned char*, int wid, int lane) const {
        using pg8::f32x4; constexpr int BM = pg8::BM, HALF = pg8::HALF;
        const int row0 = u.pm * BM + wr * 64 + fr, col0 = u.pn * BM + wc * 32 + 4 * fq;
        const float* gp = gate + (size_t)((u.pm * BM) / rows_per_batch) * gate_stride + col0;
        { f32x4 gv[2][2];
#pragma unroll
          for (int bj = 0; bj < 2; ++bj)
#pragma unroll
            for (int n = 0; n < 2; ++n) gv[bj][n] = *(const f32x4*)(gp + bj * HALF + n * 16);
#pragma unroll
          for (int ai = 0; ai < 2; ++ai)
#pragma unroll
            for (int m = 0; m < 4; ++m) { const int row = row0 + ai * HALF + m * 16; const size_t off = (size_t)row * ldc + col0; float s = 0.f;
#pragma unroll
                for (int bj = 0; bj < 2; ++bj)
#pragma unroll
                    for (int n = 0; n < 2; ++n) { const f32x4 bs = *(const f32x4*)(base + off + bj * HALF + n * 16);
                        const f32x4 x2 = bs + gv[bj][n] * acc[ai][bj][m][n]; acc[ai][bj][m][n] = x2;
                        s += (x2[0] * x2[0] + x2[1] * x2[1]) + (x2[2] * x2[2] + x2[3] * x2[3]); }
                s += __shfl_xor(s, 16); s += __shfl_xor(s, 32);
                if (fq == 0) atomicAdd(ssq + row, s);
                asm volatile("" ::: "memory"); } }
        panel_arrive_wait(cnt + 64 * u.pm, 16u * NWAVES, bar->bar + XB_TMO, wid, lane);
        const bool bad = xb_ld(bar->bar + XB_TMO) != 0u; const float q = __builtin_nanf("");
        f32x4 fv[2][2];
#pragma unroll
        for (int bj = 0; bj < 2; ++bj)
#pragma unroll
            for (int n = 0; n < 2; ++n) fv[bj][n] = *(const f32x4*)(fg + col0 + bj * HALF + n * 16);
#pragma unroll
        for (int ai = 0; ai < 2; ++ai)
#pragma unroll
            for (int m = 0; m < 4; ++m) { const int row = row0 + ai * HALF + m * 16; const size_t off = (size_t)row * ldc + col0;
                const float sv = __hip_atomic_load(ssq + row, __ATOMIC_RELAXED, __HIP_MEMORY_SCOPE_AGENT);
                const float rs = bad ? q : __builtin_amdgcn_rsqf(sv * inv_d + eps);
#pragma unroll
                for (int bj = 0; bj < 2; ++bj)
#pragma unroll
                    for (int n = 0; n < 2; ++n) *(f32x4*)(out + off + bj * HALF + n * 16) = acc[ai][bj][m][n] * rs * fv[bj][n]; }
    }
};

struct EpiNorm2 {
    static constexpr bool PERM = false, AFTER_DRAIN = false;
    __device__ __forceinline__ void operator()(pg8::f32x4 (&acc)[2][2][4][2], const pg8::Unit& u, int wr, int wc, int fr, int fq) const { fused(acc, u, wr, wc, fr, fq, nullptr, wr * 4 + wc, fq * 16 + fr); }
    const float* base; float* out; int ldc; const float* gate; int gate_stride; int rows_per_batch; float* ssq; bf16* a2; const float* n2g; const float* sc2; const float* sh2; const XcdBarrier* bar; unsigned* cnt; float inv_d, eps;
    __device__ __forceinline__ void fused(pg8::f32x4 (&acc)[2][2][4][2], const pg8::Unit& u, int wr, int wc, int fr, int fq, PG8_LAS unsigned char*, int wid, int lane) const {
        using pg8::f32x4; constexpr int BM = pg8::BM, HALF = pg8::HALF;
        const int row0 = u.pm * BM + wr * 64 + fr, col0 = u.pn * BM + wc * 32 + 4 * fq, b = (u.pm * BM) / rows_per_batch;
        { const float* gp = gate + (size_t)b * gate_stride + col0; f32x4 gv[2][2];
#pragma unroll
          for (int bj = 0; bj < 2; ++bj)
#pragma unroll
            for (int n = 0; n < 2; ++n) gv[bj][n] = *(const f32x4*)(gp + bj * HALF + n * 16);
#pragma unroll
          for (int ai = 0; ai < 2; ++ai)
#pragma unroll
            for (int m = 0; m < 4; ++m) { const int row = row0 + ai * HALF + m * 16; const size_t off = (size_t)row * ldc + col0; float s = 0.f;
#pragma unroll
                for (int bj = 0; bj < 2; ++bj)
#pragma unroll
                    for (int n = 0; n < 2; ++n) { const f32x4 bs = *(const f32x4*)(base + off + bj * HALF + n * 16);
                        const f32x4 x1 = bs + gv[bj][n] * acc[ai][bj][m][n]; acc[ai][bj][m][n] = x1; *(f32x4*)(out + off + bj * HALF + n * 16) = x1;
                        s += (x1[0] * x1[0] + x1[1] * x1[1]) + (x1[2] * x1[2] + x1[3] * x1[3]); }
                s += __shfl_xor(s, 16); s += __shfl_xor(s, 32);
                if (fq == 0) atomicAdd(ssq + row, s);
                asm volatile("" ::: "memory"); } }
        panel_arrive_wait(cnt + 64 * u.pm, 16u * NWAVES, bar->bar + XB_TMO, wid, lane);
        f32x4 cs[2][2], sv[2][2];
#pragma unroll
        for (int bj = 0; bj < 2; ++bj)
#pragma unroll
            for (int n = 0; n < 2; ++n) { const int c = col0 + bj * HALF + n * 16;
                cs[bj][n] = *(const f32x4*)(n2g + c) * (*(const f32x4*)(sc2 + (size_t)b * gate_stride + c) + 1.0f); sv[bj][n] = *(const f32x4*)(sh2 + (size_t)b * gate_stride + c); }
#pragma unroll
        for (int ai = 0; ai < 2; ++ai)
#pragma unroll
            for (int m = 0; m < 4; ++m) { const int row = row0 + ai * HALF + m * 16; const size_t off = (size_t)row * ldc + col0;
                const float rs = __builtin_amdgcn_rsqf(__hip_atomic_load(ssq + row, __ATOMIC_RELAXED, __HIP_MEMORY_SCOPE_AGENT) * inv_d + eps);
#pragma unroll
                for (int bj = 0; bj < 2; ++bj)
#pragma unroll
                    for (int n = 0; n < 2; ++n) { const f32x4 h = acc[ai][bj][m][n] * rs * cs[bj][n] + sv[bj][n];
                        v2u w; w.x = pk2(h[0], h[1]); w.y = pk2(h[2], h[3]); *(GAS v2u*)(a2 + off + bj * HALF + n * 16) = w; } }
    }
};
__device__ __forceinline__ void rg_issue_loads(const bf16* PROJ, int b, int h, int t0, int tid, v4u (&px)[3], v4u (&py)[2], bool want_y) {
#pragma unroll
    for (int k = 0; k < 3; ++k) { const int id = tid + NTHR * k, row = id >> 4, pc = id & 15, t = t0 - 3 + row; px[k] = (v4u){0u, 0u, 0u, 0u};
        if (id < (RG_TC + 3) * 16 && t >= 0) px[k] = *(const GAS v4u*)(PROJ + proj_base(T_XR, b, h) + (size_t)t * 128 + pc * 8); }
    if (want_y) {
#pragma unroll
        for (int k = 0; k < 2; ++k) { const int id = tid + NTHR * k, row = id >> 4, pc = id & 15; py[k] = *(const GAS v4u*)(PROJ + proj_base(T_YG, b, h) + (size_t)(t0 + row) * 128 + pc * 8); }
    }
}
template <int PASS> __device__ __forceinline__ void rg_span(Frame& F, int s) {
    constexpr int NQ = RG_NCH / RG_SPAN;
    const int bh = s / NQ, q = s % NQ, b = bh / NH, h = bh % NH;
    int tid_ = F.tid; asm volatile("" : "+v"(tid_));
    const int tid = tid_, lane = tid & 63, wave = F.wave;
    LAS unsigned char* XB = F.lds + RG_XB; LAS float* XF = (LAS float*)(F.lds + RG_XF); LAS float* AS = (LAS float*)(F.lds + RG_AS); LAS float* US = (LAS float*)(F.lds + RG_US);
    LAS float* SUBP = (LAS float*)(F.lds + RG_SUB); LAS float* SUBH = SUBP + 4 * 128;
    LAS unsigned char* XRAW = F.lds + RG_AS;
    LAS unsigned char* YG = F.lds + RG_YG;
    LAS unsigned char* OUT = F.lds + RG_XB;
    LAS unsigned char* OUTB = F.lds + RG_XF;
    const int ch0 = (tid & 15) * 8, chg0 = h * 128 + ch0;
    float cw[4][8], cb[8];
#pragma unroll
    for (int j = 0; j < 4; ++j) { const f32x4 w0 = *(const GAS f32x4*)(F.conv_w() + (size_t)j * RW + chg0), w1 = *(const GAS f32x4*)(F.conv_w() + (size_t)j * RW + chg0 + 4);
        cw[j][0] = w0.x; cw[j][1] = w0.y; cw[j][2] = w0.z; cw[j][3] = w0.w; cw[j][4] = w1.x; cw[j][5] = w1.y; cw[j][6] = w1.z; cw[j][7] = w1.w; }
    { const f32x4 b0 = *(const GAS f32x4*)(F.conv_b() + chg0), b1 = *(const GAS f32x4*)(F.conv_b() + chg0 + 4); cb[0] = b0.x; cb[1] = b0.y; cb[2] = b0.z; cb[3] = b0.w; cb[4] = b1.x; cb[5] = b1.y; cb[6] = b1.z; cb[7] = b1.w; }
    const int li = lane & 15, g = lane >> 4, chl = 16 * wave + li, chg = h * 128 + chl;
    bf16x8 wa[4], wi[4];
#pragma unroll
    for (int ks = 0; ks < 4; ++ks) { wa[ks] = *(const GAS bf16x8*)(F.WAT() + (size_t)h * 16384 + chl * 128 + 32 * ks + 8 * g); wi[ks] = *(const GAS bf16x8*)(F.WIT() + (size_t)h * 16384 + chl * 128 + 32 * ks + 8 * g); }
    const float nba = -1.4426950408889634f * F.rg_b_a()[chg], nbi = -1.4426950408889634f * F.rg_b_i()[chg], cl2 = -8.0f * 1.4426950408889634f * log1pf(expf(-F.lam()[chg]));
    const int sc = tid & 127, sub = tid >> 7; constexpr int SUBL = RG_TC / 4;
    float* agg = F.AGG() + (size_t)(bh * NQ) * 256;
    float carry = 0.f, prun = 1.f;
    if (PASS == 2) for (int qq = 0; qq < q; ++qq) carry = agg[qq * 256 + sc] * carry + agg[qq * 256 + 128 + sc];
    v4u px[3], py[2];
    const int tbase = q * RG_SPAN * RG_TC;
    rg_issue_loads(F.PROJ(), b, h, tbase, tid, px, py, PASS >= 2);
    for (int c = 0; c < RG_SPAN; ++c) {
        const int t0 = tbase + c * RG_TC;
#pragma unroll
        for (int k = 0; k < 3; ++k) { const int id = tid + NTHR * k; if (id < (RG_TC + 3) * 16) *(LAS v4u*)(XRAW + id * 16) = px[k]; }
        if (PASS >= 2) {
#pragma unroll
            for (int k = 0; k < 2; ++k) *(LAS v4u*)(YG + (tid + NTHR * k) * 16) = py[k]; }
        if (c + 1 < RG_SPAN) rg_issue_loads(F.PROJ(), b, h, t0 + RG_TC, tid, px, py, PASS >= 2);
        __syncthreads();
#pragma unroll
        for (int it = 0; it < (RG_TC * 16) / NTHR; ++it) { const int tt = (tid + NTHR * it) >> 4;
            float acc[8];
#pragma unroll
            for (int e = 0; e < 8; ++e) acc[e] = cb[e];
#pragma unroll
            for (int j = 0; j < 4; ++j) { const v4u xv = *(const LAS v4u*)(XRAW + (tt + j) * 256 + ch0 * 2);
                acc[0] += cw[j][0] * bf_lo(xv.x); acc[1] += cw[j][1] * bf_hi(xv.x); acc[2] += cw[j][2] * bf_lo(xv.y); acc[3] += cw[j][3] * bf_hi(xv.y);
                acc[4] += cw[j][4] * bf_lo(xv.z); acc[5] += cw[j][5] * bf_hi(xv.z); acc[6] += cw[j][6] * bf_lo(xv.w); acc[7] += cw[j][7] * bf_hi(xv.w); }
            *(LAS f32x4*)(XF + tt * 128 + ch0) = (f32x4){acc[0], acc[1], acc[2], acc[3]}; *(LAS f32x4*)(XF + tt * 128 + ch0 + 4) = (f32x4){acc[4], acc[5], acc[6], acc[7]};
            v4u o; o.x = pk2(acc[0], acc[1]); o.y = pk2(acc[2], acc[3]); o.z = pk2(acc[4], acc[5]); o.w = pk2(acc[6], acc[7]);
            *(LAS v4u*)(XB + tt * 272 + ch0 * 2) = o; }
        __syncthreads();
#pragma unroll
        for (int tb = 0; tb < RG_TC / 16; ++tb) { f32x4 ga = {0.f, 0.f, 0.f, 0.f}, gi = ga;
#pragma unroll
            for (int ks = 0; ks < 4; ++ks) { const bf16x8 xa = *(const LAS bf16x8*)(XB + (16 * tb + li) * 272 + (32 * ks + 8 * g) * 2);
                ga = __builtin_amdgcn_mfma_f32_16x16x32_bf16(xa, wa[ks], ga, 0, 0, 0); gi = __builtin_amdgcn_mfma_f32_16x16x32_bf16(xa, wi[ks], gi, 0, 0, 0); }
#pragma unroll
            for (int rg = 0; rg < 4; ++rg) { const int tok = 16 * tb + 4 * g + rg;
                const float xcv = XF[tok * 128 + chl];
                const float r = __builtin_amdgcn_rcpf(1.0f + __builtin_amdgcn_exp2f(__builtin_fmaf(ga[rg], -1.4426950408889634f, nba)));
                const float iv = __builtin_amdgcn_rcpf(1.0f + __builtin_amdgcn_exp2f(__builtin_fmaf(gi[rg], -1.4426950408889634f, nbi)));
                const float a = __builtin_amdgcn_exp2f(r * cl2);
                const float om = fmaxf(__builtin_fmaf(-a, a, 1.0f), 0.f);
                AS[tok * 128 + chl] = a; US[tok * 128 + chl] = __builtin_amdgcn_sqrtf(om) * (iv * xcv); } }
        __syncthreads();
        { float P = 1.f, H = 0.f;
#pragma unroll
          for (int k = 0; k < SUBL; ++k) { const int t = sub * SUBL + k; const float a = AS[t * 128 + sc], u = US[t * 128 + sc]; H = a * H + u; P *= a; }
          SUBP[sub * 128 + sc] = P; SUBH[sub * 128 + sc] = H; }
        __syncthreads();
        float hs = carry, ps = prun;
        { float cur = carry, pcur = prun;
#pragma unroll
          for (int k = 0; k < 4; ++k) { if (k == sub) { hs = cur; ps = pcur; } const float pk = SUBP[k * 128 + sc]; cur = pk * cur + SUBH[k * 128 + sc]; pcur *= pk; }
          carry = cur; prun = pcur; }
        if (PASS >= 2) {
#pragma unroll
            for (int k = 0; k < SUBL; ++k) { const int t = sub * SUBL + k; const float a = AS[t * 128 + sc], u = US[t * 128 + sc]; hs = a * hs + u;
                const float yg = bf_lo((unsigned)*(const LAS unsigned short*)(YG + t * 256 + sc * 2)); const float gl = gelu_tanh(yg);
                *(LAS unsigned short*)(OUT + t * 256 + sc * 2) = (unsigned short)pk2(hs * gl, 0.f);
                if (PASS == 3) { ps *= a; *(LAS unsigned short*)(OUTB + t * 256 + sc * 2) = (unsigned short)pk2(ps * gl, 0.f); } }
            __syncthreads();
#pragma unroll
            for (int k = 0; k < 2; ++k) { const int id = tid + NTHR * k, row = id >> 4, pc = id & 15;
                *(GAS v4u*)(F.HB() + (size_t)(b * SEQ + t0 + row) * D + h * 128 + pc * 8) = *(const LAS v4u*)(OUT + id * 16);
                if (PASS == 3) *(GAS v4u*)(F.PG() + (size_t)(b * SEQ + t0 + row) * RW + h * 128 + pc * 8) = *(const LAS v4u*)(OUTB + id * 16); }
        }
        __syncthreads();
    }
    if (PASS != 2 && tid < 128) { agg[q * 256 + sc] = prun; agg[q * 256 + 128 + sc] = carry; }
}

constexpr int ATT_VPITCH = 288, ATT_KBYTES = 128 * 256;
constexpr int ATT_SLOT = ATT_KBYTES + 128 * ATT_VPITCH;
static_assert(ATT_SLOT == 2 * 128 * ATT_PITCH, "ring slot size");
__device__ __forceinline__ int att_kswz(int li, int gq) { const int ob = li * 64 + gq * 16; return ob ^ (((ob >> 9) & 1) << 5); }
template <bool MERGE> __device__ __forceinline__ void attn_unit_rq(int j, int k, int& r, int& qb) {
    if (MERGE) { r = 0; qb = 8 * j + k; }
    else if (j < 2) { r = 2 * j + (k >> 3); qb = k & 7; }
    else { r = 8 * (j - 2) + (k >> 1); qb = k & 1; }
}
__device__ __forceinline__ void attn_load_block(const bf16* PROJ, int b, int h, int dsh, int r, int blk, int tid, v4u (&kx)[4], v4u (&vx)[4]) {
#pragma unroll
    for (int it = 0; it < 4; ++it) { const int id = tid + NTHR * it, row = id >> 4, pc = id & 15;
        const size_t off = (size_t)tpos(((128 * blk + row) << dsh) + r) * 128 + pc * 8;
        kx[it] = *(const GAS v4u*)(PROJ + proj_base(T_K, b, h) + off); vx[it] = *(const GAS v4u*)(PROJ + proj_base(T_V, b, h) + off); }
}
__device__ __forceinline__ void attn_load_piece(const bf16* PROJ, int b, int h, int dsh, int r, int blk, int tid, int it, bool more, v4u& kx, v4u& vx) {
    const int id = tid + NTHR * it, row = id >> 4, pc = id & 15;
    const size_t off = more ? (size_t)tpos(((128 * blk + row) << dsh) + r) * 128 + pc * 8 : (size_t)0;
    kx = *(const GAS v4u*)(PROJ + proj_base(T_K, b, h) + off); vx = *(const GAS v4u*)(PROJ + proj_base(T_V, b, h) + off);
}
__device__ __forceinline__ void attn_store_block(LAS unsigned char* slot, int tid, const v4u (&kx)[4], const v4u (&vx)[4]) {
#pragma unroll
    for (int it = 0; it < 4; ++it) { const int id = tid + NTHR * it, row = id >> 4, pc = id & 15;
        *(LAS v4u*)(slot + (row >> 4) * 4096 + (pc >> 2) * 1024 + att_kswz(row & 15, pc & 3)) = kx[it]; *(LAS v4u*)(slot + ATT_KBYTES + row * ATT_VPITCH + pc * 16) = vx[it]; }
}
template <bool MERGE> __device__ __forceinline__ void attn_run(Frame& F, int run) {
    constexpr int NU = MERGE ? 8 : 16;
    const int bh = run >> 2, j = run & 3, b = bh >> 4, h = bh & 15;
    const int p = MERGE ? 0 : (j < 2 ? 1 : 2), dsh = 2 * p;
    int tid_ = F.tid; asm volatile("" : "+v"(tid_));
    const int tid = tid_, lane = tid & 63, wave = F.wave;
    LAS unsigned char* ring = F.lds; LAS float* BS = (LAS float*)(F.lds + 2 * ATT_SLOT);
    if (tid < 160) { const int d = tid - 16; BS[tid] = (d >= 0 && d <= 128) ? 1.4426950408889634f * F.BIAS()[(p * 129 + d) * NH + h] : 0.f; }
    const int li = lane & 15, g = lane >> 4, iq = 16 * wave + li, dl = li - 4 * g;
    const LAS float* bsl = BS + 144 + dl;
    const int q4 = li >> 2, p4 = li & 3, kswz = att_kswz(li, g);
    v4u kx[4], vx[4]; bf16x8 qf[4], qn[4];
    { int r, qb; attn_unit_rq<MERGE>(j, 0, r, qb);
      attn_load_block(F.PROJ(), b, h, dsh, r, qb, tid, kx, vx); attn_store_block(ring, tid, kx, vx);
      if (qb > 0) { attn_load_block(F.PROJ(), b, h, dsh, r, qb - 1, tid, kx, vx); attn_store_block(ring + ATT_SLOT, tid, kx, vx); }
      const int pq = tpos(((qb * 128 + iq) << dsh) + r);
#pragma unroll
      for (int ks = 0; ks < 4; ++ks) qf[ks] = *(const GAS bf16x8*)(F.PROJ() + proj_base(T_Q, b, h) + (size_t)pq * 128 + 32 * ks + 8 * g); }
    __syncthreads();
    for (int k = 0; k < NU; ++k) {
        int r, qb; attn_unit_rq<MERGE>(j, k, r, qb);
        if (k > 0) { attn_store_block(ring + (k & 1) * ATT_SLOT, tid, kx, vx);
#pragma unroll
            for (int ks = 0; ks < 4; ++ks) qf[ks] = qn[ks];
            __syncthreads(); }
        int r2 = 0, qb2 = 0; const bool more = k + 1 < NU; if (more) attn_unit_rq<MERGE>(j, k + 1, r2, qb2);
        const int tq = ((qb * 128 + iq) << dsh) + r, pq = tpos(tq);
        const size_t mq = (size_t)(b * SEQ + tq);
        const size_t oidx = ((size_t)(b * NH + h) * SEQ + pq);
        v2u a1[8], a2[8]; float l1 = 0.f, l2 = 0.f;
        const bf16* o1 = F.OP() + ((size_t)1 * M * NH + oidx) * 128 + 8 * g; const bf16* o2 = F.OP() + ((size_t)2 * M * NH + oidx) * 128 + 8 * g;
        LAS unsigned char* cur = ring + (k & 1) * ATT_SLOT; LAS unsigned char* prv = ring + ((k + 1) & 1) * ATT_SLOT;
        const int xlo = (qb == 0) ? (8 - wave) : 0;
        f32x4 st[9];
        const float scale = 0.08838834764831845f * 1.4426950408889634f;
        float mx = -1e30f;
#pragma unroll
        for (int x = 0; x < 9; ++x) {
            const int T = wave + x; const LAS unsigned char* kb = (T < 8 ? prv + 4096 * T : cur + 4096 * (T - 8)) + kswz;
            f32x4 a = {0.f, 0.f, 0.f, 0.f};
#pragma unroll
            for (int ks = 0; ks < 4; ++ks) a = __builtin_amdgcn_mfma_f32_16x16x32_bf16(*(const LAS bf16x8*)(kb + 1024 * ks), qf[ks], a, 0, 0, 0);
            { constexpr int XK = MERGE ? 5 : 0;
              if (x >= XK && x < XK + 4) attn_load_piece(F.PROJ(), b, h, dsh, r2, qb2, tid, x - XK, more, kx[x - XK], vx[x - XK]); }
            if (MERGE && x < 4) { const int c0 = 2 * x; const v4u t1 = *(const GAS v4u*)(o1 + 32 * x), t2 = *(const GAS v4u*)(o2 + 32 * x);
                a1[c0] = (v2u){t1.x, t1.y}; a1[c0 + 1] = (v2u){t1.z, t1.w}; a2[c0] = (v2u){t2.x, t2.y}; a2[c0 + 1] = (v2u){t2.z, t2.w}; }
            if (MERGE && x == 0) { l1 = F.LSE()[(size_t)1 * M * NH + oidx]; l2 = F.LSE()[(size_t)2 * M * NH + oidx]; }
            if (x == 4) { const int pq2 = more ? tpos(((qb2 * 128 + iq) << dsh) + r2) : 0;
#pragma unroll
                for (int ks = 0; ks < 4; ++ks) qn[ks] = *(const GAS bf16x8*)(F.PROJ() + proj_base(T_Q, b, h) + (size_t)pq2 * 128 + 32 * ks + 8 * g); }
            const bool live = x >= xlo;
#pragma unroll
            for (int rg = 0; rg < 4; ++rg) { float sv = a[rg] * scale + bsl[-(16 * x + rg)];
                bool ok = live;
                if (x == 0) ok = ok && (dl - rg <= 0);
                if (x == 8) ok = ok && (dl - rg >= 0);
                sv = ok ? sv : -1e30f;
                a[rg] = sv; mx = fmaxf(mx, sv); }
            st[x] = a;
        }
        mx = fmaxf(mx, __shfl_xor(mx, 16)); mx = fmaxf(mx, __shfl_xor(mx, 32));
        float l = 0.f;
#pragma unroll
        for (int x = 0; x < 9; ++x)
#pragma unroll
            for (int rg = 0; rg < 4; ++rg) { const float pv = __builtin_amdgcn_exp2f(st[x][rg] - mx); st[x][rg] = pv; l += pv; }
        l += __shfl_xor(l, 16); l += __shfl_xor(l, 32);
        f32x4 o[8];
#pragma unroll
        for (int cb = 0; cb < 8; ++cb) o[cb] = (f32x4){0.f, 0.f, 0.f, 0.f};
#pragma unroll
        for (int stp = 0; stp < 5; ++stp) { const int x0 = 2 * stp, x1 = x0 + 1;
            const int T0 = (x0 >= xlo) ? wave + x0 : 8, T1 = (x1 < 9 && x1 >= xlo) ? wave + x1 : 8;
            const LAS unsigned char* v0 = (T0 < 8 ? prv + 16 * T0 * ATT_VPITCH : cur + 16 * (T0 - 8) * ATT_VPITCH) + ATT_KBYTES + (4 * g + q4) * ATT_VPITCH + 8 * p4;
            const LAS unsigned char* v1 = (T1 < 8 ? prv + 16 * T1 * ATT_VPITCH : cur + 16 * (T1 - 8) * ATT_VPITCH) + ATT_KBYTES + (4 * g + q4) * ATT_VPITCH + 8 * p4;
            bf16x8 pf; { const unsigned w0 = pk2(st[x0][0], st[x0][1]), w1 = pk2(st[x0][2], st[x0][3]);
                unsigned w2 = 0u, w3 = 0u; if (x1 < 9) { w2 = pk2(st[x1][0], st[x1][1]); w3 = pk2(st[x1][2], st[x1][3]); }
                const v4u wv = {w0, w1, w2, w3}; pf = __builtin_bit_cast(bf16x8, wv); }
            bf16x8 vf[8];
#pragma unroll
            for (int cb = 0; cb < 8; ++cb) {
                const s16x4 a0 = __builtin_amdgcn_ds_read_tr16_b64_v4i16((LAS s16x4*)(v0 + 32 * cb));
                const s16x4 a1 = __builtin_amdgcn_ds_read_tr16_b64_v4i16((LAS s16x4*)(v1 + 32 * cb));
                vf[cb] = (bf16x8){a0[0], a0[1], a0[2], a0[3], a1[0], a1[1], a1[2], a1[3]}; }
            __builtin_amdgcn_sched_barrier(0);
#pragma unroll
            for (int cb = 0; cb < 8; ++cb) o[cb] = __builtin_amdgcn_mfma_f32_16x16x32_bf16(vf[cb], pf, o[cb], 0, 0, 0);
            __builtin_amdgcn_sched_barrier(0); }
        const float inv = 1.0f / l;
        if (!MERGE) {
            bf16* orow = F.OP() + ((size_t)p * M * NH + oidx) * 128 + 8 * g;
#pragma unroll
            for (int i = 0; i < 4; ++i) { v4u w; w.x = pk2(o[2 * i][0] * inv, o[2 * i][1] * inv); w.y = pk2(o[2 * i][2] * inv, o[2 * i][3] * inv);
                w.z = pk2(o[2 * i + 1][0] * inv, o[2 * i + 1][1] * inv); w.w = pk2(o[2 * i + 1][2] * inv, o[2 * i + 1][3] * inv); *(GAS v4u*)(orow + 32 * i) = w; }
            if (g == 0) F.LSE()[(size_t)p * M * NH + oidx] = mx + __builtin_amdgcn_logf(l);
        } else {
            const float l0 = mx + __builtin_amdgcn_logf(l);
            const float lm = fmaxf(l0, fmaxf(l1, l2)); float w0 = __builtin_amdgcn_exp2f(l0 - lm), w1 = __builtin_amdgcn_exp2f(l1 - lm), w2 = __builtin_amdgcn_exp2f(l2 - lm); const float wi = __builtin_amdgcn_rcpf(w0 + w1 + w2); w0 *= wi * inv; w1 *= wi; w2 *= wi;
            bf16* orow = F.HB() + mq * D + RW + h * 128 + 4 * g;
#pragma unroll
            for (int cb = 0; cb < 8; ++cb) { const v2u a = a1[cb], c2 = a2[cb];
                v2u w; w.x = pk2(w0 * o[cb][0] + w1 * bf_lo(a.x) + w2 * bf_lo(c2.x), w0 * o[cb][1] + w1 * bf_hi(a.x) + w2 * bf_hi(c2.x));
                w.y = pk2(w0 * o[cb][2] + w1 * bf_lo(a.y) + w2 * bf_lo(c2.y), w0 * o[cb][3] + w1 * bf_hi(a.y) + w2 * bf_hi(c2.y));
                *(GAS v2u*)(orow + 16 * cb) = w; }
        }
        __syncthreads();
    }
}

__device__ __forceinline__ void groupnorm_rows(Frame& F, int m0, int nrows) {
    int lane_ = F.lane; asm volatile("" : "+v"(lane_)); const int lane = lane_;
    constexpr int NQ = RG_NCH / RG_SPAN;
    const int b = m0 / SEQ, q = (m0 % SEQ) / (RG_SPAN * RG_TC);
    f32x4 gr[4][2], ga[4][2]; float cy[4][8];
#pragma unroll
    for (int j = 0; j < 4; ++j) { const int col = 8 * (lane + 64 * j), hh = col >> 7, chl = col & 127;
        gr[j][0] = *(const GAS f32x4*)(F.gn_rec() + col); gr[j][1] = *(const GAS f32x4*)(F.gn_rec() + col + 4); ga[j][0] = *(const GAS f32x4*)(F.gn_att() + col); ga[j][1] = *(const GAS f32x4*)(F.gn_att() + col + 4);
        const float* agg = F.AGG() + (size_t)((b * NH + hh) * NQ) * 256 + chl;
#pragma unroll
        for (int e = 0; e < 8; ++e) cy[j][e] = 0.f;
        for (int qq = 0; qq < q; ++qq) { const f32x4 p0 = *(const GAS f32x4*)(agg + qq * 256), p1 = *(const GAS f32x4*)(agg + qq * 256 + 4), h0 = *(const GAS f32x4*)(agg + qq * 256 + 128), h1 = *(const GAS f32x4*)(agg + qq * 256 + 132);
            cy[j][0] = p0.x * cy[j][0] + h0.x; cy[j][1] = p0.y * cy[j][1] + h0.y; cy[j][2] = p0.z * cy[j][2] + h0.z; cy[j][3] = p0.w * cy[j][3] + h0.w;
            cy[j][4] = p1.x * cy[j][4] + h1.x; cy[j][5] = p1.y * cy[j][5] + h1.y; cy[j][6] = p1.z * cy[j][6] + h1.z; cy[j][7] = p1.w * cy[j][7] + h1.w; } }
    for (int rr = 0; rr < nrows; ++rr) {
        bf16* row = F.HB() + (size_t)(m0 + rr) * D; const bf16* prow = F.PG() + (size_t)(m0 + rr) * RW;
        v4u aw[4]; float rv[4][8]; float sr = 0.f, sa = 0.f;
#pragma unroll
        for (int j = 0; j < 4; ++j) { const int col = 8 * (lane + 64 * j); const v4u rw = *(const GAS v4u*)(row + col), pw = *(const GAS v4u*)(prow + col); aw[j] = *(const GAS v4u*)(row + RW + col);
            rv[j][0] = bf_lo(rw.x) + bf_lo(pw.x) * cy[j][0]; rv[j][1] = bf_hi(rw.x) + bf_hi(pw.x) * cy[j][1]; rv[j][2] = bf_lo(rw.y) + bf_lo(pw.y) * cy[j][2]; rv[j][3] = bf_hi(rw.y) + bf_hi(pw.y) * cy[j][3];
            rv[j][4] = bf_lo(rw.z) + bf_lo(pw.z) * cy[j][4]; rv[j][5] = bf_hi(rw.z) + bf_hi(pw.z) * cy[j][5]; rv[j][6] = bf_lo(rw.w) + bf_lo(pw.w) * cy[j][6]; rv[j][7] = bf_hi(rw.w) + bf_hi(pw.w) * cy[j][7];
            const float a0 = bf_lo(aw[j].x), a1 = bf_hi(aw[j].x), a2 = bf_lo(aw[j].y), a3 = bf_hi(aw[j].y), a4 = bf_lo(aw[j].z), a5 = bf_hi(aw[j].z), a6 = bf_lo(aw[j].w), a7 = bf_hi(aw[j].w);
#pragma unroll
            for (int e = 0; e < 8; ++e) sr += rv[j][e] * rv[j][e];
            sa += (a0 * a0 + a1 * a1) + (a2 * a2 + a3 * a3) + (a4 * a4 + a5 * a5) + (a6 * a6 + a7 * a7); }
        const float rsr = __builtin_amdgcn_rsqf(wave_sum(sr) * (1.0f / RW) + EPS), rsa = __builtin_amdgcn_rsqf(wave_sum(sa) * (1.0f / AW) + EPS);
#pragma unroll
        for (int j = 0; j < 4; ++j) { const int col = 8 * (lane + 64 * j);
            const f32x4 g0 = gr[j][0] * rsr, g1 = gr[j][1] * rsr, h0 = ga[j][0] * rsa, h1 = ga[j][1] * rsa;
            v4u w; w.x = pk2(rv[j][0] * g0.x, rv[j][1] * g0.y); w.y = pk2(rv[j][2] * g0.z, rv[j][3] * g0.w); w.z = pk2(rv[j][4] * g1.x, rv[j][5] * g1.y); w.w = pk2(rv[j][6] * g1.z, rv[j][7] * g1.w);
            *(GAS v4u*)(row + col) = w;
            v4u z; z.x = pk2(bf_lo(aw[j].x) * h0.x, bf_hi(aw[j].x) * h0.y); z.y = pk2(bf_lo(aw[j].y) * h0.z, bf_hi(aw[j].y) * h0.w);
            z.z = pk2(bf_lo(aw[j].z) * h1.x, bf_hi(aw[j].z) * h1.y); z.w = pk2(bf_lo(aw[j].w) * h1.z, bf_hi(aw[j].w) * h1.w);
            *(GAS v4u*)(row + RW + col) = z; }
    }
}

#ifndef WGM_IN
#define WGM_IN 8
#endif
#ifndef WGM_OUT
#define WGM_OUT 8
#endif
#ifndef WGM_GU
#define WGM_GU 8
#endif
#ifndef WGM_DN
#define WGM_DN 8
#endif
typedef KArgs Args;
__global__ void __launch_bounds__(NTHR, 2) hybrid_block_fwd(Args args) {
    extern __shared__ __attribute__((aligned(16))) unsigned char lds[];
    Frame F;
    F.lds = (LAS unsigned char*)lds;
    F.MISC = (volatile LAS unsigned*)(F.lds + MISC_OFF);
    F.tid = threadIdx.x; F.lane = F.tid & 63; F.wave = __builtin_amdgcn_readfirstlane(F.tid >> 6);
    F.G = gridDim.x; { const int bx = blockIdx.x; F.vcu = (F.G % 8 == 0) ? (bx % 8) * (F.G / 8) + bx / 8 : bx; }
    F.A = kargs();
    F.ctl = (gu32*)(F.A->ws + WS_CTL);
    if (F.tid < 64) ((LAS unsigned*)(F.lds + MISC_OFF))[F.tid] = 0u;
    __syncthreads();
    XcdBarrier bar = xcd_barrier_post((unsigned*)(F.ctl + CW_BAR), F.MISC + 8);
    const int gw = F.vcu * NWAVES + F.wave, NGW = F.G * NWAVES;

    p0_prologue(F);
    xcd_barrier(bar); F.A = kargs();
    for (int i = F.vcu * NTHR + F.tid; i < BATCH * NADA; i += F.G * NTHR) { const int b = i / NADA, n = i % NADA; float s = F.ada_b()[n];
#pragma unroll
        for (int ks = 0; ks < ADA_KS; ++ks) s += F.MODP()[(size_t)(ks * BATCH + b) * NADA + n];
        F.MOD()[i] = s; }
    xcd_barrier(bar); F.A = kargs();
    for (int m = gw; m < M; m += NGW) { const float* mod = F.MOD() + (size_t)(m / SEQ) * NADA; norm_mod_row(F.x() + (size_t)m * D, F.HB() + (size_t)m * D, F.norm1_g(), mod + D, mod, F.lane); }
    xcd_barrier(bar); F.A = kargs();
    { pg8::Gemm g{F.HB(), F.WIN(), M, NPROJ, D}; pg8::StaticOrder S; S.init(M, NPROJ, F.G, (int)blockIdx.x, WGM_IN); pg8::EpiProj E{F.PROJ(), SEQ, NH};
      pg8::gemm_phase<pg8::EpiProj, pg8::StaticOrder, false, PG8_SP2>(F.lds, g, S, E); }
    xcd_barrier(bar); F.A = kargs();
    for (int run = F.vcu; run < BATCH * NH * 4; run += F.G) attn_run<false>(F, run);
    xcd_barrier(bar); F.A = kargs();
    if (F.vcu & 1) { for (int run = F.vcu; run < BATCH * NH * 4; run += F.G) attn_run<true>(F, run); }
    for (int s = F.vcu; s < RG_NSPAN; s += F.G) rg_span<3>(F, s);
    if (!(F.vcu & 1)) { for (int run = F.vcu; run < BATCH * NH * 4; run += F.G) attn_run<true>(F, run); }
    xcd_barrier(bar); F.A = kargs();
    for (int m0 = 8 * gw; m0 < M; m0 += 8 * NGW) groupnorm_rows(F, m0, 8);
    xcd_barrier(bar); F.A = kargs();
    if (F.G == 256) {
        { pg8::Gemm g{F.HB(), F.WOUT(), M, D, D}; PanelRoundOrder S{(int)blockIdx.x, 4};
          EpiNorm2 E{F.x(), F.X1(), D, F.MOD() + 2 * D, NADA, SEQ, F.SSQ2(), F.HB2(), F.norm2_g(), F.MOD() + 4 * D, F.MOD() + 3 * D, &bar, F.PCNT(0), 1.0f / D, EPS};
          pg8::gemm_phase<EpiNorm2, PanelRoundOrder, true, PG8_SP2>(F.lds, g, S, E); }
        xcd_barrier(bar); F.A = kargs();
    } else {
        { pg8::Gemm g{F.HB(), F.WOUT(), M, D, D}; pg8::StaticOrder S; S.init(M, D, F.G, (int)blockIdx.x, WGM_OUT); pg8::EpiResGate E{F.x(), F.X1(), D, F.MOD() + 2 * D, NADA, SEQ};
          pg8::gemm_phase<pg8::EpiResGate, pg8::StaticOrder, PG8_ALIGN, PG8_SP2>(F.lds, g, S, E); }
        xcd_barrier(bar); F.A = kargs();
        for (int m = gw; m < M; m += NGW) { const float* mod = F.MOD() + (size_t)(m / SEQ) * NADA; norm_mod_row(F.X1() + (size_t)m * D, F.HB2() + (size_t)m * D, F.norm2_g(), mod + 4 * D, mod + 3 * D, F.lane); }
        xcd_barrier(bar); F.A = kargs();
    }
    { pg8::Gemm g{F.HB2(), F.WGU(), M, NGU, D}; pg8::StaticOrder S; S.init(M, NGU, F.G, (int)blockIdx.x, WGM_GU); pg8::EpiSwiGLU E{F.U(), DFF};
      pg8::gemm_phase<pg8::EpiSwiGLU, pg8::StaticOrder, false, PG8_SP2>(F.lds, g, S, E);
      const int nun = (M / 256) * (NGU / 256), rem = nun % F.G, bx = (int)blockIdx.x;
      __syncthreads();
      if (rem == 0) tr_down_tail(F, bx, F.G); else if (bx >= rem) tr_down_tail(F, bx - rem, F.G - rem); }
    xcd_barrier(bar); F.A = kargs();
    if (F.G == 256) {
        { pg8::Gemm g{F.U(), F.WDN(), M, D, DFF}; PanelRoundOrder S{(int)blockIdx.x, 4};
          EpiFinalNorm E{F.X1(), F.out(), D, F.MOD() + 5 * D, NADA, SEQ, F.SSQ3(), F.final_g(), &bar, F.PCNT(1), 1.0f / D, EPS};
          pg8::gemm_phase<EpiFinalNorm, PanelRoundOrder, true, PG8_SP2>(F.lds, g, S, E); }
    } else {
        { pg8::Gemm g{F.U(), F.WDN(), M, D, DFF}; pg8::StaticOrder S; S.init(M, D, F.G, (int)blockIdx.x, WGM_DN); pg8::EpiResGate E{F.X1(), F.out(), D, F.MOD() + 5 * D, NADA, SEQ};
          pg8::gemm_phase<pg8::EpiResGate, pg8::StaticOrder, PG8_ALIGN, PG8_SP2>(F.lds, g, S, E); }
        xcd_barrier(bar); F.A = kargs();
        const bool bad = xb_ld((unsigned*)(F.ctl + CW_BAR) + XB_TMO) != 0u; const float q = __builtin_nanf("");
        for (int m = gw; m < M; m += NGW) { norm_row_f32(F.out() + (size_t)m * D, F.out() + (size_t)m * D, F.final_g(), F.lane);
            if (bad) { GAS f32x4* o = (GAS f32x4*)(F.out() + (size_t)m * D) + F.lane; o[0] = (f32x4){q, q, q, q}; } }
    }
}

extern "C" void kernel_launch(void* const* d_in, const int* in_sizes, int n_in, void* d_out, int out_size, void* d_ws, size_t ws_size, hipStream_t stream) {
    static int grid = 0;
    if (grid == 0) {
        if (n_in != 22 || in_sizes[0] != M * D || out_size != M * D || ws_size < WS_END) { fprintf(stderr, "kernel_launch: unexpected shapes (n_in %d, in0 %d, out %d, ws %zu); nothing launched\n", n_in, n_in > 0 ? in_sizes[0] : -1, out_size, ws_size); grid = -1; return; }
        int dev = 0, cus = 0, per_cu = 0;
        if (hipGetDevice(&dev) != hipSuccess || hipDeviceGetAttribute(&cus, hipDeviceAttributeMultiprocessorCount, dev) != hipSuccess) { fprintf(stderr, "kernel_launch: device query failed\n"); grid = -1; return; }
        if (hipFuncSetAttribute((const void*)hybrid_block_fwd, hipFuncAttributeMaxDynamicSharedMemorySize, LDS_BYTES) != hipSuccess) { fprintf(stderr, "kernel_launch: hipFuncSetAttribute failed\n"); grid = -1; return; }
        if (hipOccupancyMaxActiveBlocksPerMultiprocessor(&per_cu, (const void*)hybrid_block_fwd, NTHR, LDS_BYTES) != hipSuccess || per_cu < 1)
            fprintf(stderr, "kernel_launch: note: occupancy query reports %d workgroups per CU\n", per_cu);
        (void)hipGetLastError();
        grid = cus;
    }
    if (grid < 0) return;
    if (hipMemsetAsync((char*)d_ws + WS_CTL, 0, CTL_ZERO_BYTES, stream) != hipSuccess) { fprintf(stderr, "kernel_launch: memset failed\n"); return; }
    Args a{};
    for (int i = 0; i < 22; ++i) a.in[i] = (const float*)d_in[i];
    a.out = (float*)d_out; a.ws = (unsigned char*)d_ws;
    hipLaunchKernelGGL(hybrid_block_fwd, dim3(grid), dim3(NTHR), LDS_BYTES, stream, a);
    const hipError_t le = hipPeekAtLastError();
    if (le != hipSuccess) fprintf(stderr, "kernel_launch: launch failed: %s\n", hipGetErrorName(le));
}
```
